# Optimizing an MI355X kernel written in HIP

```python
import math
import jax, jax.numpy as jnp
from jax import lax
import numpy as np

D_MODEL = 1024
BATCH = 8
SEQ = 4096
DEPTH = 2

MIX_WIDTH = D_MODEL
DIFF_HEADS = 4
DIFF_QK_DIM = 64
DIFF_V_DIM = 2 * DIFF_QK_DIM
DIFF_ROT_DIM = DIFF_QK_DIM // 4
ROPE_THETA = 500000.0
MLA_HEADS = 4
MLA_Q_RANK = 256
MLA_KV_RANK = 128
MLA_NOPE_DIM = 128
MLA_ROPE_DIM = 64
MLA_QK_DIM = MLA_NOPE_DIM + MLA_ROPE_DIM
MLA_V_DIM = 128
MLA_ROPE_THETA = 10000.0
DIFF_QK_COLS = DIFF_HEADS * 2 * DIFF_QK_DIM
DIFF_V_COLS = DIFF_HEADS * DIFF_V_DIM
IN_SPLITS = [
    DIFF_QK_COLS,
    2 * DIFF_QK_COLS,
    2 * DIFF_QK_COLS + DIFF_V_COLS,
    2 * DIFF_QK_COLS + DIFF_V_COLS + MLA_Q_RANK,
    2 * DIFF_QK_COLS + DIFF_V_COLS + MLA_Q_RANK + MLA_KV_RANK,
]
IN_COLS = IN_SPLITS[-1] + MLA_ROPE_DIM
OUT_COLS = DIFF_HEADS * DIFF_V_DIM + MLA_HEADS * MLA_V_DIM
D_FF = 2816
N_EXPERTS = 8
TOP_K = 2
D_FF_EXPERT = D_FF // TOP_K
N_DENSE_LAYERS = (DEPTH + 1) // 2
N_MOE_LAYERS = DEPTH // 2
Q_BLOCK = 128
NORM_EPS = 1e-6

kernel_name = "hybrid_diffattn_mla_moe_block"


def rms_norm(x, g):
    xf = x.astype(jnp.float32)
    y = xf * lax.rsqrt(jnp.mean(xf * xf, axis=-1, keepdims=True) + NORM_EPS)
    return (y * g.astype(jnp.float32)).astype(x.dtype)


def rope(x, positions, theta):
    rot = x.shape[-1]
    half = rot // 2
    inv_freq = 1.0 / (theta ** (jnp.arange(half, dtype=jnp.float32) * (2.0 / rot)))
    ang = positions.astype(jnp.float32)[:, None] * inv_freq[None, :]
    bshape = (1, ang.shape[0]) + (1,) * (x.ndim - 3) + (half,)
    cos = jnp.cos(ang).reshape(bshape)
    sin = jnp.sin(ang).reshape(bshape)
    xf = x.astype(jnp.float32)
    x1, x2 = xf[..., :half], xf[..., half:]
    return jnp.concatenate([x1 * cos - x2 * sin, x2 * cos + x1 * sin], axis=-1).astype(x.dtype)


def causal_mask(i, seq):
    qpos = i * Q_BLOCK + jnp.arange(Q_BLOCK)
    kpos = jnp.arange(seq)
    return kpos[None, :] <= qpos[:, None]


def masked_softmax(s, mask):
    return jax.nn.softmax(jnp.where(mask, s, -jnp.inf), axis=-1)


def causal_query_blocks(block_fn, queries):
    b, s = queries[0].shape[:2]
    nb = s // Q_BLOCK
    qb = tuple(jnp.moveaxis(a.reshape(b, nb, Q_BLOCK, *a.shape[2:]), 1, 0) for a in queries)
    out = lax.map(lambda args: block_fn(args[0], args[1]), (qb, jnp.arange(nb)))
    out = jnp.moveaxis(out, 0, 1)
    return out.reshape(b, s, *out.shape[3:])


def differential_attention(q, k, v, q_g, k_g, lam_params, subln_g, layer_idx, positions):
    b, s, _ = q.shape
    q = q.reshape(b, s, DIFF_HEADS, 2, DIFF_QK_DIM)
    k = k.reshape(b, s, DIFF_HEADS, 2, DIFF_QK_DIM)
    v = v.reshape(b, s, DIFF_HEADS, DIFF_V_DIM)
    q = rms_norm(q, q_g)
    k = rms_norm(k, k_g)
    q = jnp.concatenate([rope(q[..., :DIFF_ROT_DIM], positions, ROPE_THETA), q[..., DIFF_ROT_DIM:]], axis=-1)
    k = jnp.concatenate([rope(k[..., :DIFF_ROT_DIM], positions, ROPE_THETA), k[..., DIFF_ROT_DIM:]], axis=-1)
    lam_init = 0.8 - 0.6 * math.exp(-0.3 * layer_idx)
    lp = lam_params.astype(jnp.float32)
    lam = jnp.exp(jnp.sum(lp[0] * lp[1])) - jnp.exp(jnp.sum(lp[2] * lp[3])) + lam_init
    scale = DIFF_QK_DIM ** -0.5
    k1, k2 = k[..., 0, :], k[..., 1, :]

    def block(qs, i):
        q1b, q2b = qs
        mask = causal_mask(i, s)
        s1 = jnp.einsum('bqhd,bkhd->bhqk', q1b, k1).astype(jnp.float32) * scale
        s2 = jnp.einsum('bqhd,bkhd->bhqk', q2b, k2).astype(jnp.float32) * scale
        p = masked_softmax(s1, mask) - lam * masked_softmax(s2, mask)
        return jnp.einsum('bhqk,bkhe->bqhe', p.astype(v.dtype), v)

    o = causal_query_blocks(block, (q[..., 0, :], q[..., 1, :]))
    o = rms_norm(o, subln_g) * (1.0 - lam_init)
    return o.reshape(b, s, DIFF_HEADS * DIFF_V_DIM)


def latent_attention(c_q, c_kv, k_pe, q_ln_g, w_uq, kv_ln_g, w_ukv, qk_g, positions):
    b, s, _ = c_q.shape
    q = (rms_norm(c_q, q_ln_g) @ w_uq).reshape(b, s, MLA_HEADS, MLA_QK_DIM)
    kv = (rms_norm(c_kv, kv_ln_g) @ w_ukv).reshape(b, s, MLA_HEADS, MLA_NOPE_DIM + MLA_V_DIM)
    k_nope, v = kv[..., :MLA_NOPE_DIM], kv[..., MLA_NOPE_DIM:]
    k_pe = jnp.broadcast_to(k_pe[:, :, None, :], (b, s, MLA_HEADS, MLA_ROPE_DIM))
    k = jnp.concatenate([k_nope, k_pe], axis=-1)
    q = rms_norm(q, qk_g[0])
    k = rms_norm(k, qk_g[1])
    q = jnp.concatenate([q[..., :MLA_NOPE_DIM], rope(q[..., MLA_NOPE_DIM:], positions, MLA_ROPE_THETA)], axis=-1)
    k = jnp.concatenate([k[..., :MLA_NOPE_DIM], rope(k[..., MLA_NOPE_DIM:], positions, MLA_ROPE_THETA)], axis=-1)
    scale = MLA_QK_DIM ** -0.5

    def block(qs, i):
        (qb,) = qs
        sc = jnp.einsum('bqhd,bkhd->bhqk', qb, k).astype(jnp.float32) * scale
        p = masked_softmax(sc, causal_mask(i, s))
        return jnp.einsum('bhqk,bkhe->bqhe', p.astype(v.dtype), v)

    o = causal_query_blocks(block, (q,))
    return o.reshape(b, s, MLA_HEADS * MLA_V_DIM)


def swiglu(h, wg, wu, wd):
    return (jax.nn.silu(h @ wg) * (h @ wu)) @ wd


def moe_swiglu(h, router_w, wg, wu, wd):
    logits = (h @ router_w).astype(jnp.float32)
    top_logits, top_idx = lax.top_k(logits, TOP_K)
    gates = jax.nn.softmax(top_logits, axis=-1)
    combine = jnp.einsum('bsk,bske->bse', gates,
                         jax.nn.one_hot(top_idx, N_EXPERTS, dtype=jnp.float32)).astype(h.dtype)
    out = jnp.zeros_like(h)
    for e in range(N_EXPERTS):
        out = out + combine[..., e:e + 1] * swiglu(h, wg[e], wu[e], wd[e])
    return out


def setup_inputs(seed: int = 0) -> dict:
    key = jax.random.key(seed)
    ks = jax.random.split(key, 24)
    f32 = jnp.float32

    def nrm(k, shape, scale):
        return jax.random.normal(k, shape, f32) * scale

    def gain(k, shape):
        return 1.0 + 0.02 * jax.random.normal(k, shape, f32)

    return {
        "x": nrm(ks[0], (BATCH, SEQ, D_MODEL), 1.0),
        "attn_norm_g": gain(ks[1], (DEPTH, D_MODEL)),
        "w_in": nrm(ks[2], (DEPTH, D_MODEL, IN_COLS), D_MODEL ** -0.5),
        "diff_q_norm_g": gain(ks[3], (DEPTH, DIFF_QK_DIM)),
        "diff_k_norm_g": gain(ks[4], (DEPTH, DIFF_QK_DIM)),
        "diff_lambda": nrm(ks[5], (DEPTH, 4, DIFF_QK_DIM), 0.1),
        "diff_subln_g": gain(ks[6], (DEPTH, DIFF_V_DIM)),
        "mla_q_ln_g": gain(ks[7], (DEPTH, MLA_Q_RANK)),
        "w_uq": nrm(ks[8], (DEPTH, MLA_Q_RANK, MLA_HEADS * MLA_QK_DIM), MLA_Q_RANK ** -0.5),
        "mla_kv_ln_g": gain(ks[9], (DEPTH, MLA_KV_RANK)),
        "w_ukv": nrm(ks[10], (DEPTH, MLA_KV_RANK, MLA_HEADS * (MLA_NOPE_DIM + MLA_V_DIM)), MLA_KV_RANK ** -0.5),
        "mla_qk_norm_g": gain(ks[11], (DEPTH, 2, MLA_QK_DIM)),
        "w_o": nrm(ks[12], (DEPTH, OUT_COLS, D_MODEL), OUT_COLS ** -0.5),
        "ffn_norm_g": gain(ks[13], (DEPTH, D_MODEL)),
        "dense_w_gate": nrm(ks[14], (N_DENSE_LAYERS, D_MODEL, D_FF), D_MODEL ** -0.5),
        "dense_w_up": nrm(ks[15], (N_DENSE_LAYERS, D_MODEL, D_FF), D_MODEL ** -0.5),
        "dense_w_down": nrm(ks[16], (N_DENSE_LAYERS, D_FF, D_MODEL), D_FF ** -0.5),
        "router_w": nrm(ks[17], (N_MOE_LAYERS, D_MODEL, N_EXPERTS), D_MODEL ** -0.5),
        "moe_w_gate": nrm(ks[18], (N_MOE_LAYERS, N_EXPERTS, D_MODEL, D_FF_EXPERT), D_MODEL ** -0.5),
        "moe_w_up": nrm(ks[19], (N_MOE_LAYERS, N_EXPERTS, D_MODEL, D_FF_EXPERT), D_MODEL ** -0.5),
        "moe_w_down": nrm(ks[20], (N_MOE_LAYERS, N_EXPERTS, D_FF_EXPERT, D_MODEL), D_FF_EXPERT ** -0.5),
    }


def reference(x, attn_norm_g, w_in, diff_q_norm_g, diff_k_norm_g, diff_lambda, diff_subln_g,
              mla_q_ln_g, w_uq, mla_kv_ln_g, w_ukv, mla_qk_norm_g, w_o, ffn_norm_g,
              dense_w_gate, dense_w_up, dense_w_down, router_w, moe_w_gate, moe_w_up, moe_w_down):
    positions = jnp.arange(x.shape[1], dtype=jnp.int32)
    for l in range(DEPTH):
        h = rms_norm(x, attn_norm_g[l])
        proj = h @ w_in[l]
        dq, dk, dv, c_q, c_kv, k_pe = jnp.split(proj, IN_SPLITS, axis=-1)
        a_out = differential_attention(dq, dk, dv, diff_q_norm_g[l], diff_k_norm_g[l],
                                       diff_lambda[l], diff_subln_g[l], l, positions)
        b_out = latent_attention(c_q, c_kv, k_pe, mla_q_ln_g[l], w_uq[l], mla_kv_ln_g[l],
                                 w_ukv[l], mla_qk_norm_g[l], positions)
        x = x + jnp.concatenate([a_out, b_out], axis=-1) @ w_o[l]
        h = rms_norm(x, ffn_norm_g[l])
        j = l // 2
        if l % 2 == 0:
            x = x + swiglu(h, dense_w_gate[j], dense_w_up[j], dense_w_down[j])
        else:
            x = x + moe_swiglu(h, router_w[j], moe_w_gate[j], moe_w_up[j], moe_w_down[j])
    return x
```

```cpp
#include <hip/hip_runtime.h>
#include <cstdio>
#include <cstdint>

#ifndef MK_PER_PHASE
#define MK_PER_PHASE 0
#endif
#ifndef PH_MASK
#define PH_MASK 0xFFFF
#endif
#ifndef ATT_SEL
#define ATT_SEL 7
#endif
#define PH_ON(j) (((PH_MASK) >> (j)) & 1)
#ifndef DUP_MASK
#define DUP_MASK 0
#endif
#ifndef DUP_BAR
#define DUP_BAR 0
#endif
#ifndef I8_IN
#define I8_IN 1
#endif
#ifndef I8_MOE
#define I8_MOE 1
#endif
#ifndef FP8_GU
#define FP8_GU 2
#endif
#ifndef PROBE_NULL_GU
#define PROBE_NULL_GU 0
#endif
#define REP(j) ((((DUP_MASK) >> (j)) & 1) ? 2 : 1)

constexpr int BATCH = 8, SEQ = 4096, DM = 1024, DEPTH = 2;
constexpr int M = BATCH * SEQ;
constexpr int INC = 1984, INCP = 2048;
constexpr int DFF = 2816, DFFE = 1408, NEXP = 8;
constexpr int MQR = 256, MKR = 128;
constexpr int SLOTS = 2 * M + NEXP * 256;
constexpr float EPS = 1e-6f;
constexpr float LOG2E = 1.4426950408889634f;

constexpr size_t MiB = 1u << 20;
constexpr size_t WS_CTL = 0, CTL_ZERO_BYTES = 64 * 1024;
constexpr size_t WS_SS = 1 * MiB;
constexpr size_t WS_ROPD = 3 * MiB;
constexpr size_t WS_ROPM = WS_ROPD + 256 * 1024;
constexpr size_t WS_MISC = WS_ROPM + 1 * MiB;
constexpr size_t WS_RW = WS_MISC + 64 * 1024;
constexpr size_t WS_CNT = WS_RW + 32 * 1024;
constexpr size_t WS_TOKE = 5 * MiB;
constexpr size_t WS_TOKG = WS_TOKE + (size_t)M * 4;
constexpr size_t WS_RSC = WS_TOKG + (size_t)M * 8;
constexpr size_t WS_SLOT = WS_RSC + (size_t)M * 4;
constexpr size_t WS_RS = WS_SLOT + (size_t)M * 8;
constexpr size_t WS_KPESS = WS_RS + (size_t)SLOTS * 4;
constexpr size_t WS_WMOE_GU = 8 * MiB;
constexpr size_t WS_WMOE_D = 52 * MiB;
constexpr size_t WS_W1 = 74 * MiB;
constexpr size_t WS_XB = 81 * MiB;
constexpr size_t WS_AO = 145 * MiB;
constexpr size_t WS_QM = 209 * MiB;
constexpr size_t WS_KVU = 257 * MiB;
constexpr size_t WS_KM = 321 * MiB;
constexpr size_t WS_W0 = 369 * MiB;
constexpr size_t WS_PROJ1 = 369 * MiB;
constexpr size_t WS_ACT0 = 145 * MiB;
constexpr size_t WS_XG = 145 * MiB;
constexpr size_t WS_ACTG = 277 * MiB;
constexpr size_t WS_END = 497 * MiB;
constexpr size_t WOFF_IN = 0, WOFF_UQ = 4 * MiB, WOFF_UKV = WOFF_UQ + 512 * 1024, WOFF_O = WOFF_UKV + 256 * 1024, WOFF_GU = WOFF_O + 2 * MiB, WOFF_D = WOFF_GU + 11 * MiB;
static_assert(WS_KPESS + (size_t)M * 4 <= WS_WMOE_GU && WOFF_D + (size_t)DM * DFF * 2 <= 24 * MiB && WS_ACTG + (size_t)SLOTS * DFFE * 2 <= WS_END && WS_XG + (size_t)SLOTS * DM * 2 <= WS_ACTG, "d_ws map");
static_assert(WS_ACT0 + (size_t)M * DFF * 2 <= WS_W0, "dense act clear of layer-0 weights");

constexpr int CW_TMO = 0, CW_BAR = 4096, CW_TAIL = 8192;
constexpr int MI_LAM = 0, MI_BIASD = 2, MI_BIASM = 4, MI_MOEC = 16;
constexpr int MI_GT = 1024, GT_L = 1024, GT_GQ = 0, GT_GK = 64, GT_QLN = 128, GT_KVLN = 384, GT_QK = 512, GT_SUB = 896;

constexpr int NWAVES = 8;
constexpr int RING_BYTES = 131072, LDSCTL_OFF = RING_BYTES, MISC_OFF = LDSCTL_OFF + 320;
constexpr int LDS_BYTES = 147456;
constexpr int PART_OFF = RING_BYTES + 1024;

constexpr float WQ_I8 = 127.0f * 32.0f / 4.5f;
namespace pg8 {
#define PG8_LAS __attribute__((address_space(3)))
typedef unsigned short bf16_t;
typedef short bf16x8 __attribute__((ext_vector_type(8)));
typedef float f32x4 __attribute__((ext_vector_type(4)));
typedef unsigned u32x4 __attribute__((ext_vector_type(4)));
typedef int i32x4 __attribute__((ext_vector_type(4)));
typedef int i32x8 __attribute__((ext_vector_type(8)));
constexpr int BM = 256, BK = 64, HALF = 128, HTB = HALF * BK * 2, STAGE_BYTES = 8 * HTB, NXCD = 8, WGM = 8;

__host__ __device__ __forceinline__ int lds_byte(int r, int c) { const int st = (r >> 4) * 2 + (c >> 5), rr = r & 15, cc = c & 31, ob = rr * 64 + cc * 2; return st * 1024 + (ob ^ (((ob >> 9) & 1) << 5)); }
__host__ __device__ __forceinline__ void stage_rc(int b, int& R, int& C) { const int st = b / 1024, sb = b % 1024, swz = sb ^ (((sb >> 9) & 1) << 5); R = (st >> 1) * 16 + swz / 64; C = (st & 1) * 32 + (swz % 64) / 2; }
__host__ __device__ __forceinline__ int perm32(int rho) { const int n = rho >> 4, i = rho & 15; return 8 * (i >> 2) + 4 * n + (i & 3); }

struct Unit { int pm, pn, cn; };
struct Gemm { const bf16_t* A; const bf16_t* Bt; int lda, K, ldb; };

struct StaticOrder {
    int nM, nN, nwg, G, c;
    __device__ void init(int M_, int N_, int G_, int c_) { nM = M_ / BM; nN = N_ / BM; nwg = nM * nN; G = G_; c = c_; }
    __device__ bool next(int i, Unit& u) const {
        const long L = (long)i * G + c; if (L >= nwg) return false;
        int wgid = (int)L; { const int q = nwg / NXCD, r = nwg % NXCD, xcd = wgid % NXCD, off = wgid / NXCD; wgid = (xcd < r ? xcd * (q + 1) : r * (q + 1) + (xcd - r) * q) + off; }
        const int nig = WGM * nN, gid = wgid / nig, fm = gid * WGM, gsz = (nM - fm) < WGM ? (nM - fm) : WGM;
        u.pm = fm + ((wgid % nig) % gsz); u.pn = (wgid % nig) / gsz; u.cn = u.pn; return true;
    }
};
struct MoeOrder {
    int c1, c2, c3, c4, c5, c6, c7, rlo, rhi, ncol, G, c;
    __device__ bool next(int i, Unit& u) const {
        const int L = i * G + c; if (L >= (rhi - rlo) * ncol) return false;
        const int q = L / ncol, rt = rlo + q, j = L - q * ncol;
        const int e = (rt >= c1) + (rt >= c2) + (rt >= c3) + (rt >= c4) + (rt >= c5) + (rt >= c6) + (rt >= c7);
        u.pm = rt; u.pn = e * ncol + j; u.cn = j; return true;
    }
};

struct OneUnit { Unit u; int on; __device__ bool next(int i, Unit& o) const { if (i != 0 || !on) return false; o = u; return true; } };

__device__ __forceinline__ unsigned cvt_pk_bf16(float lo, float hi) { unsigned r; asm volatile("v_cvt_pk_bf16_f32 %0, %1, %2" : "=v"(r) : "v"(lo), "v"(hi)); return r; }
__device__ __forceinline__ u32x4 pack8(f32x4 a, f32x4 b) { u32x4 w; w.x = cvt_pk_bf16(a[0], a[1]); w.y = cvt_pk_bf16(a[2], a[3]); w.z = cvt_pk_bf16(b[0], b[1]); w.w = cvt_pk_bf16(b[2], b[3]); return w; }
__device__ __forceinline__ float row_scale16(const float* ss, int row, int fq) {
    const f32x4 p = *(const f32x4*)(ss + (size_t)row * 16 + 4 * fq); float s = (p[0] + p[1]) + (p[2] + p[3]);
    s += __shfl_xor(s, 16); s += __shfl_xor(s, 32); return 1.0f / sqrtf(s * (1.0f / 1024.0f) + EPS);
}
struct RsPref { f32x4 a, b, c, d; };
__device__ __forceinline__ void rs_issue(RsPref& r, const float* ss, int direct, int pm, int tid) {
    if (tid < 256) { const int row = pm * BM + tid;
        if (direct) { r.a[0] = ss[row]; }
        else { const f32x4* p = (const f32x4*)(ss + (size_t)row * 16); r.a = p[0]; r.b = p[1]; r.c = p[2]; r.d = p[3]; } }
}
__device__ __forceinline__ void rs_commit(const RsPref& r, int direct, PG8_LAS float* rs, int parity, int tid) {
    if (tid < 256) { float v;
        if (direct) v = r.a[0];
        else { const f32x4 t = (r.a + r.b) + (r.c + r.d); v = 1.0f / sqrtf(((t[0] + t[1]) + (t[2] + t[3])) * (1.0f / 1024.0f) + EPS); }
        rs[parity * 256 + tid] = v; }
}
struct EpiScaleBf16 {
    static constexpr bool PERM = true, PREF = false;
    bf16_t* O; int ldc; const float* ss;
    __device__ __forceinline__ void operator()(const f32x4 (&acc)[2][2][4][2], const Unit& u, int wr, int wc, int fr, int fq, int par) const {
        const int row0 = u.pm * BM + wr * 64 + fr, col0 = u.cn * BM + wc * 32 + 8 * fq;
#pragma unroll
        for (int ai = 0; ai < 2; ++ai)
#pragma unroll
            for (int m = 0; m < 4; ++m) { const int row = row0 + ai * HALF + m * 16; float sc = 1.f; if (ss) sc = row_scale16(ss, row, fq);
                bf16_t* rowp = O + (size_t)row * ldc + col0;
#pragma unroll
                for (int bj = 0; bj < 2; ++bj) *(u32x4*)(rowp + bj * HALF) = pack8(acc[ai][bj][m][0] * sc, acc[ai][bj][m][1] * sc); }
    }
};
struct EpiInProj {
    static constexpr bool PERM = true, PREF = true; static constexpr int direct = I8_IN ? 1 : 0;
    bf16_t* PROJ; unsigned char* wsb; const float* gt; PG8_LAS float* part; const float* ss; PG8_LAS float* rsl; bf16_t* cqn;
    __device__ __forceinline__ void operator()(f32x4 (&acc)[2][2][4][2], const Unit& u, int wr, int wc, int fr, int fq, int par) const {
        bf16_t* const CQN = cqn; bf16_t* const CKVN = cqn + (size_t)M * MQR;
        const float* const ropd = (const float*)(wsb + WS_ROPD); const float* const ropm = (const float*)(wsb + WS_ROPM);
        bf16_t* const KPR = (bf16_t*)(wsb + WS_KVU + 32 * MiB); float* const kpess = (float*)(wsb + WS_KPESS);
        const float* const gq = gt + GT_GQ; const float* const gk = gt + GT_GK; const float* const gqln = gt + GT_QLN; const float* const gkvln = gt + GT_KVLN; const float* const gk192 = gt + GT_QK + 192;
        int rl0_ = wr * 64 + fr; asm volatile("" : "+v"(rl0_));
        const int rl0 = rl0_, row0 = u.pm * BM + rl0, cn = u.cn;
        PG8_LAS float* const pw = part + rl0 * 8 + wc; PG8_LAS float* const px = part + rl0 * 8 + (wc ^ 1); PG8_LAS float* const p0 = part + rl0 * 8;
#pragma unroll
        for (int ai = 0; ai < 2; ++ai)
#pragma unroll
            for (int m = 0; m < 4; ++m) { const int rl = rl0 + ai * HALF + m * 16; const float rx = rsl[par * 256 + rl] * (I8_IN ? 1.0f / WQ_I8 : 1.0f);
#pragma unroll
                for (int bj = 0; bj < 2; ++bj) { f32x4 v0 = acc[ai][bj][m][0] * rx, v1 = acc[ai][bj][m][1] * rx; acc[ai][bj][m][0] = v0; acc[ai][bj][m][1] = v1;
                    float q = (v0[0] * v0[0] + v0[1] * v0[1]) + (v0[2] * v0[2] + v0[3] * v0[3]) + (v1[0] * v1[0] + v1[1] * v1[1]) + (v1[2] * v1[2] + v1[3] * v1[3]);
                    q += __shfl_xor(q, 16); q += __shfl_xor(q, 32);
                    if (fq == 0) pw[(ai * HALF + m * 16) * 8 + bj * 4] = q; } }
        asm volatile("s_waitcnt lgkmcnt(0)\n\ts_barrier" ::: "memory");
        const int cw = wc * 32 + 8 * fq;
        if (cn < 4) {
            const bool isq = cn < 2; const float* gp = isq ? gq : gk; const float gsc = isq ? 0.125f * LOG2E : 1.0f;
            float gv[8];
#pragma unroll
            for (int e = 0; e < 8; ++e) gv[e] = gp[(cw & 63) + e] * gsc;
            const bool ropew = (wc & 1) == 0;
#pragma unroll
            for (int ai = 0; ai < 2; ++ai)
#pragma unroll
                for (int m = 0; m < 4; ++m) { const int rl = rl0 + ai * HALF + m * 16, row = u.pm * BM + rl;
                    float cs[8], sn[8];
                    if (ropew) { const float* rp = ropd + (size_t)(row & (SEQ - 1)) * 16; const f32x4 c0 = *(const f32x4*)rp, c1 = *(const f32x4*)(rp + 4), s0 = *(const f32x4*)(rp + 8), s1 = *(const f32x4*)(rp + 12);
#pragma unroll
                        for (int e = 0; e < 4; ++e) { cs[e] = c0[e]; cs[4 + e] = c1[e]; sn[e] = s0[e]; sn[4 + e] = s1[e]; } }
#pragma unroll
                    for (int bj = 0; bj < 2; ++bj) { const float sq = pw[(ai * HALF + m * 16) * 8 + bj * 4] + px[(ai * HALF + m * 16) * 8 + bj * 4]; const float rinv = 1.0f / sqrtf(sq * (1.0f / 64.0f) + EPS);
                        float v[8];
#pragma unroll
                        for (int e = 0; e < 4; ++e) { v[e] = acc[ai][bj][m][0][e] * rinv * gv[e]; v[4 + e] = acc[ai][bj][m][1][e] * rinv * gv[4 + e]; }
                        if (ropew) {
#pragma unroll
                            for (int e = 0; e < 8; ++e) { const float other = __shfl_xor(v[e], 16);
                                if (fq == 0) v[e] = v[e] * cs[e] - other * sn[e]; else if (fq == 1) v[e] = v[e] * cs[e] + other * sn[e]; } }
                        *(u32x4*)(PROJ + (size_t)row * INCP + cn * BM + bj * HALF + cw) = pack8((f32x4){v[0], v[1], v[2], v[3]}, (f32x4){v[4], v[5], v[6], v[7]}); }
                    asm volatile("" ::: "memory"); }
        } else if (cn < 6) {
#pragma unroll
            for (int ai = 0; ai < 2; ++ai)
#pragma unroll
                for (int m = 0; m < 4; ++m) { const int row = row0 + ai * HALF + m * 16;
#pragma unroll
                    for (int bj = 0; bj < 2; ++bj) *(u32x4*)(PROJ + (size_t)row * INCP + cn * BM + bj * HALF + cw) = pack8(acc[ai][bj][m][0], acc[ai][bj][m][1]); }
        } else if (cn == 6) {
            float gv[2][8];
#pragma unroll
            for (int bj = 0; bj < 2; ++bj)
#pragma unroll
                for (int e = 0; e < 8; ++e) gv[bj][e] = gqln[bj * HALF + cw + e];
#pragma unroll
            for (int ai = 0; ai < 2; ++ai)
#pragma unroll
                for (int m = 0; m < 4; ++m) { const int rl = rl0 + ai * HALF + m * 16, row = u.pm * BM + rl;
                    const f32x4 pa = *(const PG8_LAS f32x4*)(p0 + (ai * HALF + m * 16) * 8), pb = *(const PG8_LAS f32x4*)(p0 + (ai * HALF + m * 16) * 8 + 4);
                    const float rinv = 1.0f / sqrtf(((pa[0] + pa[1]) + (pa[2] + pa[3]) + (pb[0] + pb[1]) + (pb[2] + pb[3])) * (1.0f / 256.0f) + EPS);
#pragma unroll
                    for (int bj = 0; bj < 2; ++bj) { f32x4 v0 = acc[ai][bj][m][0] * rinv, v1 = acc[ai][bj][m][1] * rinv;
#pragma unroll
                        for (int e = 0; e < 4; ++e) { v0[e] *= gv[bj][e]; v1[e] *= gv[bj][4 + e]; }
                        *(u32x4*)(CQN + (size_t)row * 256 + bj * HALF + cw) = pack8(v0, v1); } }
        } else {
            float gv[8], gkp[8];
#pragma unroll
            for (int e = 0; e < 8; ++e) { gv[e] = gkvln[cw + e]; const int p = (cw & 63) + e; gkp[e] = gk192[128 + (p >> 1) + 32 * (p & 1)]; }
#pragma unroll
            for (int ai = 0; ai < 2; ++ai)
#pragma unroll
                for (int m = 0; m < 4; ++m) { const int rl = rl0 + ai * HALF + m * 16, row = u.pm * BM + rl;
                    const f32x4 pa = *(const PG8_LAS f32x4*)(p0 + (ai * HALF + m * 16) * 8);
                    const float rinv = 1.0f / sqrtf(((pa[0] + pa[1]) + (pa[2] + pa[3])) * (1.0f / 128.0f) + EPS);
                    f32x4 v0 = acc[ai][0][m][0] * rinv, v1 = acc[ai][0][m][1] * rinv;
#pragma unroll
                    for (int e = 0; e < 4; ++e) { v0[e] *= gv[e]; v1[e] *= gv[4 + e]; }
                    *(u32x4*)(CKVN + (size_t)row * 128 + cw) = pack8(v0, v1);
                    if (wc < 2) {
                        const f32x4 pb = *(const PG8_LAS f32x4*)(p0 + (ai * HALF + m * 16) * 8 + 4);
                        if (wc == 0 && fq == 0) kpess[row] = pb[0] + pb[1];
                        const float* rp = ropm + (size_t)(row & (SEQ - 1)) * 64 + (cw >> 1); const f32x4 c4 = *(const f32x4*)rp, s4 = *(const f32x4*)(rp + 32);
                        float x[8];
#pragma unroll
                        for (int e = 0; e < 4; ++e) { x[e] = acc[ai][1][m][0][e] * gkp[e]; x[4 + e] = acc[ai][1][m][1][e] * gkp[4 + e]; }
                        float y[8];
#pragma unroll
                        for (int j = 0; j < 4; ++j) { y[2 * j] = x[2 * j] * c4[j] - x[2 * j + 1] * s4[j]; y[2 * j + 1] = x[2 * j + 1] * c4[j] + x[2 * j] * s4[j]; }
                        *(u32x4*)(KPR + (size_t)row * 64 + cw) = pack8((f32x4){y[0], y[1], y[2], y[3]}, (f32x4){y[4], y[5], y[6], y[7]}); }
                    asm volatile("" ::: "memory"); }
        }
    }
};
struct EpiMlaQ {
    static constexpr bool PERM = true, PREF = false;
    bf16_t* QM; const float* ropm; const float* g; PG8_LAS float* part;
    __device__ __forceinline__ void operator()(f32x4 (&acc)[2][2][4][2], const Unit& u, int wr, int wc, int fr, int fq, int par) const {
        int rl0_ = wr * 64 + fr; asm volatile("" : "+v"(rl0_));
        const int rl0 = rl0_, h = u.cn, cw = wc * 32 + 8 * fq;
        PG8_LAS float* const pw = part + rl0 * 8 + wc; PG8_LAS float* const p0 = part + rl0 * 8;
#pragma unroll
        for (int ai = 0; ai < 2; ++ai)
#pragma unroll
            for (int m = 0; m < 4; ++m)
#pragma unroll
                for (int bj = 0; bj < 2; ++bj) { const f32x4 v0 = acc[ai][bj][m][0], v1 = acc[ai][bj][m][1];
                    float q = (v0[0] * v0[0] + v0[1] * v0[1]) + (v0[2] * v0[2] + v0[3] * v0[3]) + (v1[0] * v1[0] + v1[1] * v1[1]) + (v1[2] * v1[2] + v1[3] * v1[3]);
                    q += __shfl_xor(q, 16); q += __shfl_xor(q, 32);
                    if (fq == 0) pw[(ai * HALF + m * 16) * 8 + bj * 4] = q; }
        asm volatile("s_waitcnt lgkmcnt(0)\n\ts_barrier" ::: "memory");
        constexpr float C2 = 0.07216878364870322f * LOG2E;
        float g0[8], g1[8];
#pragma unroll
        for (int e = 0; e < 8; ++e) { g0[e] = g[cw + e] * C2; const int p = (cw & 63) + e; g1[e] = g[128 + (p >> 1) + 32 * (p & 1)] * C2; }
#pragma unroll
        for (int ai = 0; ai < 2; ++ai)
#pragma unroll
            for (int m = 0; m < 4; ++m) { const int row = u.pm * BM + rl0 + ai * HALF + m * 16;
                const f32x4 pa = *(const PG8_LAS f32x4*)(p0 + (ai * HALF + m * 16) * 8), pb = *(const PG8_LAS f32x4*)(p0 + (ai * HALF + m * 16) * 8 + 4);
                const float rinv = 1.0f / sqrtf(((pa[0] + pa[1]) + (pa[2] + pa[3]) + (pb[0] + pb[1]) + (pb[2] + pb[3])) * (1.0f / 192.0f) + EPS);
                { f32x4 v0 = acc[ai][0][m][0] * rinv, v1 = acc[ai][0][m][1] * rinv;
#pragma unroll
                  for (int e = 0; e < 4; ++e) { v0[e] *= g0[e]; v1[e] *= g0[4 + e]; }
                  *(u32x4*)(QM + (size_t)row * 768 + h * 192 + cw) = pack8(v0, v1); }
                if (wc < 2) { const float* rp = ropm + (size_t)(row & (SEQ - 1)) * 64 + (cw >> 1); const f32x4 c4 = *(const f32x4*)rp, s4 = *(const f32x4*)(rp + 32);
                    float x[8], y[8];
#pragma unroll
                    for (int e = 0; e < 4; ++e) { x[e] = acc[ai][1][m][0][e] * rinv * g1[e]; x[4 + e] = acc[ai][1][m][1][e] * rinv * g1[4 + e]; }
#pragma unroll
                    for (int j = 0; j < 4; ++j) { y[2 * j] = x[2 * j] * c4[j] - x[2 * j + 1] * s4[j]; y[2 * j + 1] = x[2 * j + 1] * c4[j] + x[2 * j] * s4[j]; }
                    *(u32x4*)(QM + (size_t)row * 768 + h * 192 + 128 + cw) = pack8((f32x4){y[0], y[1], y[2], y[3]}, (f32x4){y[4], y[5], y[6], y[7]}); }
                asm volatile("" ::: "memory"); }
    }
};
struct EpiMlaKV {
    static constexpr bool PERM = true, PREF = false;
    bf16_t* KM; const bf16_t* KPR; const float* kpess; const float* g; PG8_LAS float* part;
    __device__ __forceinline__ void operator()(f32x4 (&acc)[2][2][4][2], const Unit& u, int wr, int wc, int fr, int fq, int par) const {
        int rl0_ = wr * 64 + fr; asm volatile("" : "+v"(rl0_));
        const int rl0 = rl0_, h0 = 2 * u.cn, cw = wc * 32 + 8 * fq;
        PG8_LAS float* const pw = part + rl0 * 8 + wc; PG8_LAS float* const p0 = part + rl0 * 8;
#pragma unroll
        for (int ai = 0; ai < 2; ++ai)
#pragma unroll
            for (int m = 0; m < 4; ++m)
#pragma unroll
                for (int bj = 0; bj < 2; ++bj) { const f32x4 v0 = acc[ai][bj][m][0], v1 = acc[ai][bj][m][1];
                    float q = (v0[0] * v0[0] + v0[1] * v0[1]) + (v0[2] * v0[2] + v0[3] * v0[3]) + (v1[0] * v1[0] + v1[1] * v1[1]) + (v1[2] * v1[2] + v1[3] * v1[3]);
                    q += __shfl_xor(q, 16); q += __shfl_xor(q, 32);
                    if (fq == 0) pw[(ai * HALF + m * 16) * 8 + bj * 4] = q; }
        asm volatile("s_waitcnt lgkmcnt(0)\n\ts_barrier" ::: "memory");
        float g0[8];
#pragma unroll
        for (int e = 0; e < 8; ++e) g0[e] = g[cw + e];
#pragma unroll
        for (int ai = 0; ai < 2; ++ai)
#pragma unroll
            for (int m = 0; m < 4; ++m) { const int row = u.pm * BM + rl0 + ai * HALF + m * 16;
                const f32x4 pa = *(const PG8_LAS f32x4*)(p0 + (ai * HALF + m * 16) * 8), pb = *(const PG8_LAS f32x4*)(p0 + (ai * HALF + m * 16) * 8 + 4);
                const float kp = kpess[row];
                float rinv[2];
                rinv[0] = 1.0f / sqrtf((((pa[0] + pa[1]) + (pa[2] + pa[3])) + kp) * (1.0f / 192.0f) + EPS);
                rinv[1] = 1.0f / sqrtf((((pb[0] + pb[1]) + (pb[2] + pb[3])) + kp) * (1.0f / 192.0f) + EPS);
#pragma unroll
                for (int bj = 0; bj < 2; ++bj) { f32x4 v0 = acc[ai][bj][m][0] * rinv[bj], v1 = acc[ai][bj][m][1] * rinv[bj];
#pragma unroll
                    for (int e = 0; e < 4; ++e) { v0[e] *= g0[e]; v1[e] *= g0[4 + e]; }
                    *(u32x4*)(KM + (size_t)row * 768 + (h0 + bj) * 192 + cw) = pack8(v0, v1); }
                if (wc < 2) { const u32x4 w = *(const u32x4*)(KPR + (size_t)row * 64 + cw);
                    f32x4 a, b; a[0] = __builtin_bit_cast(float, w.x << 16); a[1] = __builtin_bit_cast(float, w.x & 0xffff0000u); a[2] = __builtin_bit_cast(float, w.y << 16); a[3] = __builtin_bit_cast(float, w.y & 0xffff0000u);
                    b[0] = __builtin_bit_cast(float, w.z << 16); b[1] = __builtin_bit_cast(float, w.z & 0xffff0000u); b[2] = __builtin_bit_cast(float, w.w << 16); b[3] = __builtin_bit_cast(float, w.w & 0xffff0000u);
#pragma unroll
                    for (int bj = 0; bj < 2; ++bj) *(u32x4*)(KM + (size_t)row * 768 + (h0 + bj) * 192 + 128 + cw) = pack8(a * rinv[bj], b * rinv[bj]); }
                asm volatile("" ::: "memory"); }
    }
};
struct EpiNull {
    static constexpr bool PERM = true, PREF = false;
    float* sink;
    __device__ __forceinline__ void operator()(f32x4 (&acc)[2][2][4][2], const Unit& u, int wr, int wc, int fr, int fq, int par) const {
        float t = 0.f;
#pragma unroll
        for (int ai = 0; ai < 2; ++ai)
#pragma unroll
            for (int bj = 0; bj < 2; ++bj)
#pragma unroll
                for (int m = 0; m < 4; ++m)
#pragma unroll
                    for (int n = 0; n < 2; ++n) t += (acc[ai][bj][m][n][0] + acc[ai][bj][m][n][1]) + (acc[ai][bj][m][n][2] + acc[ai][bj][m][n][3]);
        if (t == 12345.678f) sink[u.pm * 256 + wr * 64 + fr] = t;
    }
};
__device__ __forceinline__ float silu_mul(float g, float u) { return g * u * __builtin_amdgcn_rcpf(1.0f + __builtin_amdgcn_exp2f(-g * LOG2E)); }
template <int MODE> struct EpiProbe {
    static constexpr bool PERM = true, PREF = false;
    bf16_t* O; int ldc; const float* ss; float* sink;
    __device__ __forceinline__ void operator()(f32x4 (&acc)[2][2][4][2], const Unit& u, int wr, int wc, int fr, int fq, int par) const {
        const int row0 = u.pm * BM + wr * 64 + fr, col0 = u.cn * HALF + wc * 32 + 8 * fq; float t = 0.f;
#pragma unroll
        for (int ai = 0; ai < 2; ++ai)
#pragma unroll
            for (int m = 0; m < 4; ++m) { const int row = row0 + ai * HALF + m * 16;
                if (MODE == 2) { const float sc = row_scale16(ss, row, fq);
#pragma unroll
                    for (int e = 0; e < 4; ++e) { t += silu_mul(acc[ai][0][m][0][e] * sc, acc[ai][1][m][0][e] * sc); t += silu_mul(acc[ai][0][m][1][e] * sc, acc[ai][1][m][1][e] * sc); } }
                else { *(u32x4*)(O + (size_t)(row & 8191) * ldc + col0) = pack8(acc[ai][0][m][0] + acc[ai][1][m][0], acc[ai][0][m][1] + acc[ai][1][m][1]); } }
        if (MODE == 2 && t == 12345.678f) sink[row0] = t;
    }
};
struct EpiSwiGLU {
    static constexpr bool PERM = true, PREF = true;
    bf16_t* O; int ldc; const float* ss; int direct; PG8_LAS float* rsl; float wsc;
    __device__ __forceinline__ void operator()(const f32x4 (&acc)[2][2][4][2], const Unit& u, int wr, int wc, int fr, int fq, int par) const {
        const int row0 = u.pm * BM + wr * 64 + fr, col0 = u.cn * HALF + wc * 32 + 8 * fq;
#pragma unroll
        for (int ai = 0; ai < 2; ++ai)
#pragma unroll
            for (int m = 0; m < 4; ++m) { const int row = row0 + ai * HALF + m * 16; const float sc = rsl[par * 256 + wr * 64 + fr + ai * HALF + m * 16] * wsc;
                f32x4 h0, h1;
#pragma unroll
                for (int e = 0; e < 4; ++e) { h0[e] = silu_mul(acc[ai][0][m][0][e] * sc, acc[ai][1][m][0][e] * sc); h1[e] = silu_mul(acc[ai][0][m][1][e] * sc, acc[ai][1][m][1][e] * sc); }
                __builtin_nontemporal_store(pack8(h0, h1), (u32x4*)(O + (size_t)row * ldc + col0)); }
    }
};
struct EpiResid {
    static constexpr bool PERM = true, PREF = false;
    bf16_t* xb; float* ss; unsigned char* x8;
    __device__ __forceinline__ void operator()(f32x4 (&acc)[2][2][4][2], const Unit& u, int wr, int wc, int fr, int fq, int par) const {
        const int row0 = u.pm * BM + wr * 64 + fr, col0 = u.cn * BM + wc * 32 + 8 * fq;
#pragma unroll
        for (int ai = 0; ai < 2; ++ai)
#pragma unroll
            for (int m = 0; m < 4; ++m) { const int row = row0 + ai * HALF + m * 16; const size_t off = (size_t)row * DM + col0; float q = 0.f;
#pragma unroll
                for (int bj = 0; bj < 2; ++bj) { const u32x4 w = *(const u32x4*)(xb + off + bj * HALF);
                    f32x4 a, b;
                    a[0] = __builtin_bit_cast(float, w.x << 16); a[1] = __builtin_bit_cast(float, w.x & 0xffff0000u); a[2] = __builtin_bit_cast(float, w.y << 16); a[3] = __builtin_bit_cast(float, w.y & 0xffff0000u);
                    b[0] = __builtin_bit_cast(float, w.z << 16); b[1] = __builtin_bit_cast(float, w.z & 0xffff0000u); b[2] = __builtin_bit_cast(float, w.w << 16); b[3] = __builtin_bit_cast(float, w.w & 0xffff0000u);
                    const f32x4 v0 = a + acc[ai][bj][m][0], v1 = b + acc[ai][bj][m][1];
                    *(u32x4*)(xb + off + bj * HALF) = pack8(v0, v1);
                    if (x8) { int w0 = __builtin_amdgcn_cvt_pk_fp8_f32(v0[0], v0[1], 0, false); w0 = __builtin_amdgcn_cvt_pk_fp8_f32(v0[2], v0[3], w0, true);
                        int w1 = __builtin_amdgcn_cvt_pk_fp8_f32(v1[0], v1[1], 0, false); w1 = __builtin_amdgcn_cvt_pk_fp8_f32(v1[2], v1[3], w1, true);
                        *(unsigned long long*)(x8 + off + bj * HALF) = (unsigned long long)(unsigned)w0 | ((unsigned long long)(unsigned)w1 << 32); }
                    q += (v0[0] * v0[0] + v0[1] * v0[1]) + (v0[2] * v0[2] + v0[3] * v0[3]) + (v1[0] * v1[0] + v1[1] * v1[1]) + (v1[2] * v1[2] + v1[3] * v1[3]); }
                q += __shfl_xor(q, 16); q += __shfl_xor(q, 32);
                if (fq == 0) ss[(size_t)row * 16 + u.cn * 4 + wc] = q; }
    }
};


template <class Epi, class Sched, bool ALIGN_EPI = true, int QM = 0>
__device__ __forceinline__ void gemm_phase(PG8_LAS unsigned char* lds, const Gemm g, const Sched& S, const Epi& E) {
    int tid_ = threadIdx.x; asm volatile("" : "+v"(tid_));
    const int tid = tid_, wid = __builtin_amdgcn_readfirstlane(tid >> 6), lane = tid & 63, wr = wid >> 2, wc = wid & 3, fr = lane & 15, fq = lane >> 4;
    int K_ = g.K, lda_ = g.lda, ldb_ = g.ldb ? g.ldb : g.K; asm volatile("" : "+s"(K_), "+s"(lda_), "+s"(ldb_));
    const int K = K_, nt = K / BK, lda = lda_, ldb = ldb_;
    unsigned voffA[2], voffB[2];
#pragma unroll
    for (int i = 0; i < 2; ++i) { int R, C; stage_rc(tid * 16 + i * 8192, R, C); const int Rb = Epi::PERM ? ((R & ~31) + perm32(R & 31)) : R;
        voffA[i] = (unsigned)(R * lda + C) * 2u; voffB[i] = (unsigned)(Rb * ldb + C) * 2u; }
    const size_t kstep = (size_t)(BK * 2);
    const size_t hstepA = (size_t)HALF * lda * 2, tstepA = 2 * hstepA, hstepB = (size_t)HALF * ldb * 2, tstepB = 2 * hstepB;
    const unsigned ldsw = (unsigned)wid * 1024u;
    const int aoff = lds_byte(wr * 64 + fr, fq * 8), boff = lds_byte(wc * 32 + fr, fq * 8);
#define PG8_SA(b, h) (((b) * 2 + (h)) * HTB)
#define PG8_SB(b, h) ((4 + (b) * 2 + (h)) * HTB)
#define PG8_STAGE(bufoff, gbase, voff) do { _Pragma("unroll") for (int _i = 0; _i < 2; ++_i) \
        __builtin_amdgcn_global_load_lds((const unsigned*)((const char*)(gbase) + (voff)[_i]), (PG8_LAS unsigned*)(lds + (bufoff) + ldsw + _i * 8192), 16, 0, 0); } while (0)
#define PG8_LDA(dst, b, h) do { _Pragma("unroll") for (int m = 0; m < 4; ++m) _Pragma("unroll") for (int k = 0; k < 2; ++k) dst[m][k] = *(const PG8_LAS bf16x8*)(lds + PG8_SA(b, h) + aoff + m * 2048 + k * 1024); } while (0)
#define PG8_LDB(dst, b, h) do { _Pragma("unroll") for (int n = 0; n < 2; ++n) _Pragma("unroll") for (int k = 0; k < 2; ++k) dst[n][k] = *(const PG8_LAS bf16x8*)(lds + PG8_SB(b, h) + boff + n * 2048 + k * 1024); } while (0)
#define PG8_CAT8(x0, x1) __builtin_shufflevector(__builtin_bit_cast(i32x4, x0), __builtin_bit_cast(i32x4, x1), 0, 1, 2, 3, 4, 5, 6, 7)
#define PG8_MMA(ai, bj, At, Bt) do { __builtin_amdgcn_s_setprio(1); _Pragma("unroll") for (int m = 0; m < 4; ++m) _Pragma("unroll") for (int n = 0; n < 2; ++n) { \
        if constexpr (QM == 1) { const i32x8 b8_ = PG8_CAT8(Bt[n][0], Bt[n][1]), a8_ = PG8_CAT8(At[m][0], At[m][1]); asm volatile("v_mfma_f32_16x16x128_f8f6f4 %0, %1, %2, %0" : "+v"(acc[ai][bj][m][n]) : "v"(b8_), "v"(a8_)); } \
        else if constexpr (QM == 2) { _Pragma("unroll") for (int k = 0; k < 2; ++k) acc[ai][bj][m][n] = __builtin_bit_cast(f32x4, __builtin_amdgcn_mfma_i32_16x16x64_i8(__builtin_bit_cast(i32x4, Bt[n][k]), __builtin_bit_cast(i32x4, At[m][k]), __builtin_bit_cast(i32x4, acc[ai][bj][m][n]), 0, 0, 0)); } \
        else { _Pragma("unroll") for (int k = 0; k < 2; ++k) acc[ai][bj][m][n] = __builtin_amdgcn_mfma_f32_16x16x32_bf16(Bt[n][k], At[m][k], acc[ai][bj][m][n], 0, 0, 0); } } \
        __builtin_amdgcn_s_setprio(0); } while (0)
#define PG8_WAIT_V(n) asm volatile("s_waitcnt vmcnt(" #n ")" ::: "memory")
#define PG8_WAIT_L(n) asm volatile("s_waitcnt lgkmcnt(" #n ")" ::: "memory")
#define PG8_BAR __builtin_amdgcn_s_barrier()
#define PG8_SCHED __builtin_amdgcn_sched_barrier(0)
    Unit cur, nxt; int ui = 0;
    if (!S.next(0, cur)) return;
    if constexpr (Epi::PREF) { RsPref r0_; rs_issue(r0_, E.ss, E.direct, cur.pm, tid); rs_commit(r0_, E.direct, E.rsl, 0, tid); }
    f32x4 acc[2][2][4][2];
#pragma unroll
    for (int a = 0; a < 2; ++a)
#pragma unroll
        for (int b = 0; b < 2; ++b)
#pragma unroll
            for (int m = 0; m < 4; ++m)
#pragma unroll
                for (int n = 0; n < 2; ++n) acc[a][b][m][n] = (f32x4){0.f, 0.f, 0.f, 0.f};
    bf16x8 At[4][2], B0[2][2], B1[2][2];
    const char* cA = (const char*)g.A + (size_t)cur.pm * tstepA; const char* cB = (const char*)g.Bt + (size_t)cur.pn * tstepB;
    PG8_STAGE(PG8_SB(0, 0), cB, voffB); PG8_STAGE(PG8_SB(0, 1), cB + hstepB, voffB); PG8_STAGE(PG8_SA(0, 0), cA, voffA); PG8_STAGE(PG8_SA(0, 1), cA + hstepA, voffA);
    if (wr == 1) PG8_BAR;
    PG8_WAIT_V(2); PG8_BAR;
    PG8_STAGE(PG8_SB(1, 0), cB + kstep, voffB); PG8_STAGE(PG8_SA(1, 0), cA + kstep, voffA); PG8_STAGE(PG8_SB(1, 1), cB + hstepB + kstep, voffB);
    PG8_WAIT_V(6); PG8_BAR;
    for (;;) {
        const bool has_next = S.next(ui + 1, nxt);
        const char* nA = has_next ? (const char*)g.A + (size_t)nxt.pm * tstepA : cA; const char* nB = has_next ? (const char*)g.Bt + (size_t)nxt.pn * tstepB : cB;
        for (int t = 0; t < nt; t += 2) {
            const bool last = (t == nt - 2);
            const char* a1 = cA + (size_t)(t + 1) * kstep;
            const char* a2 = last ? nA : cA + (size_t)(t + 2) * kstep; const char* b2 = last ? nB : cB + (size_t)(t + 2) * kstep;
            const char* a3 = a2 + kstep; const char* b3 = b2 + kstep;
            PG8_LDB(B0, 0, 0); PG8_LDB(B1, 0, 1); PG8_SCHED; PG8_LDA(At, 0, 0); PG8_STAGE(PG8_SA(1, 1), a1 + hstepA, voffA);
            PG8_WAIT_V(8); PG8_WAIT_L(0); PG8_BAR; PG8_MMA(0, 0, At, B0); PG8_MMA(0, 1, At, B1); PG8_BAR; PG8_SCHED;
            PG8_LDA(At, 0, 1); PG8_STAGE(PG8_SB(0, 0), b2, voffB); PG8_STAGE(PG8_SB(0, 1), b2 + hstepB, voffB); PG8_STAGE(PG8_SA(0, 0), a2, voffA);
            PG8_WAIT_V(8); PG8_WAIT_L(0); PG8_BAR; PG8_MMA(1, 0, At, B0); PG8_MMA(1, 1, At, B1); PG8_BAR; PG8_SCHED;
            PG8_LDB(B0, 1, 0); PG8_LDB(B1, 1, 1); PG8_SCHED; PG8_LDA(At, 1, 0); PG8_STAGE(PG8_SA(0, 1), a2 + hstepA, voffA);
            PG8_WAIT_V(8); PG8_WAIT_L(0); PG8_BAR; PG8_MMA(0, 0, At, B0); PG8_MMA(0, 1, At, B1); PG8_BAR; PG8_SCHED;
            PG8_LDA(At, 1, 1); PG8_STAGE(PG8_SB(1, 0), b3, voffB); PG8_STAGE(PG8_SB(1, 1), b3 + hstepB, voffB); PG8_STAGE(PG8_SA(1, 0), a3, voffA);
            PG8_WAIT_V(8); PG8_WAIT_L(0); PG8_BAR; PG8_MMA(1, 0, At, B0); PG8_MMA(1, 1, At, B1); PG8_BAR; PG8_SCHED;
        }
        if constexpr (QM == 2) {
#pragma unroll
            for (int a = 0; a < 2; ++a)
#pragma unroll
                for (int b = 0; b < 2; ++b)
#pragma unroll
                    for (int m = 0; m < 4; ++m)
#pragma unroll
                        for (int n = 0; n < 2; ++n) { const i32x4 t_ = __builtin_bit_cast(i32x4, acc[a][b][m][n]); acc[a][b][m][n] = (f32x4){(float)t_[0], (float)t_[1], (float)t_[2], (float)t_[3]}; } }
        if constexpr (QM == 1) asm volatile("s_nop 15\n\ts_nop 15" ::: "memory");
        if constexpr (ALIGN_EPI) { if (wr == 0) PG8_BAR; }
        RsPref rp_; if constexpr (Epi::PREF) { if (has_next) rs_issue(rp_, E.ss, E.direct, nxt.pm, tid); }
        { int fr_ = fr, fq_ = fq; asm volatile("" : "+v"(fr_), "+v"(fq_)); E(acc, cur, wr, wc, fr_, fq_, ui & 1); }
        if constexpr (Epi::PREF) { if (has_next) rs_commit(rp_, E.direct, E.rsl, (ui + 1) & 1, tid); }
        if (!has_next) break;
#pragma unroll
        for (int a = 0; a < 2; ++a)
#pragma unroll
            for (int b = 0; b < 2; ++b)
#pragma unroll
                for (int m = 0; m < 4; ++m)
#pragma unroll
                    for (int n = 0; n < 2; ++n) acc[a][b][m][n] = (f32x4){0.f, 0.f, 0.f, 0.f};
        cur = nxt; cA = nA; cB = nB; ++ui;
        if constexpr (ALIGN_EPI) { if (wr == 1) PG8_BAR; }
    }
    PG8_WAIT_V(0);
    if constexpr (!ALIGN_EPI) { if (wr == 0) PG8_BAR; }
    PG8_BAR;
#undef PG8_SA
#undef PG8_SB
#undef PG8_STAGE
#undef PG8_LDA
#undef PG8_LDB
#undef PG8_MMA
#undef PG8_WAIT_V
#undef PG8_WAIT_L
#undef PG8_BAR
#undef PG8_SCHED
}
}

namespace att {
typedef unsigned short bf16;
typedef short bf16x8 __attribute__((ext_vector_type(8)));
typedef short s16x4 __attribute__((ext_vector_type(4)));
typedef float f32x16 __attribute__((ext_vector_type(16)));
typedef float f32x4 __attribute__((ext_vector_type(4)));
typedef unsigned u32x4 __attribute__((ext_vector_type(4)));
constexpr int NW = 8, QBLK = 32, KVBLK = 64, QB = 256;
constexpr int SHM_V = KVBLK * 128 * 2;
#define SBAR() __builtin_amdgcn_sched_barrier(0)
__device__ __forceinline__ int v_st(int k, int c) { const int kk = (k & ~0xC) | ((k & 4) << 1) | ((k & 8) >> 1); return ((kk >> 3) * 4 + (c >> 5)) * 512 + ((kk & 7) * 32 + (c & 31)) * 2; }
__device__ __forceinline__ int v_rd_base(int lane) { return ((lane & 3) << 3) | (((lane >> 2) & 3) << 6) | (((lane >> 4) & 1) << 5) | (((lane >> 5) & 1) << 8); }
constexpr int v_rd_off(int d0, int ks, int half) { return d0 * 512 + ks * 4096 + half * 2048; }
__device__ __forceinline__ int crow(int r, int hi) { return (r & 3) + 8 * (r >> 2) + 4 * hi; }
__device__ __forceinline__ unsigned cvtpk(float lo, float hi) { unsigned r; asm volatile("v_cvt_pk_bf16_f32 %0, %1, %2" : "=v"(r) : "v"(lo), "v"(hi)); return r; }

__device__ __forceinline__ void mask_tile(f32x16& p0, f32x16& p1, int dq) {
    const float NEG = -__builtin_inff();
#pragma unroll
    for (int r = 0; r < 16; ++r) { const int c = (r & 3) + 8 * (r >> 2); if (c > dq) p0[r] = NEG; if (c + 32 > dq) p1[r] = NEG; }
}
__device__ __forceinline__ void expA(f32x16& p0) {
#pragma unroll
    for (int r = 0; r < 16; ++r) p0[r] = __builtin_amdgcn_exp2f(p0[r]);
}
__device__ __forceinline__ void finishSM(f32x16& p0, f32x16& p1, float& l_reg, bf16x8& pa0, bf16x8& pa1, bf16x8& pa2, bf16x8& pa3) {
#pragma unroll
    for (int r = 0; r < 16; ++r) p1[r] = __builtin_amdgcn_exp2f(p1[r]);
    float ps = 0;
#pragma unroll
    for (int r = 0; r < 16; ++r) ps += p0[r];
#pragma unroll
    for (int r = 0; r < 16; ++r) ps += p1[r];
    l_reg += ps;
#define PK4(P, B_, OUT) do { unsigned a0 = cvtpk(P[B_+0], P[B_+1]), a1 = cvtpk(P[B_+2], P[B_+3]);                          \
        unsigned b0 = cvtpk(P[B_+4], P[B_+5]), b1 = cvtpk(P[B_+6], P[B_+7]);                                             \
        auto r0 = __builtin_amdgcn_permlane32_swap(a0, b0, false, false); auto r1 = __builtin_amdgcn_permlane32_swap(a1, b1, false, false); \
        u32x4 w = {r0[0], r1[0], r0[1], r1[1]}; OUT = *reinterpret_cast<bf16x8*>(&w); } while (0)
    PK4(p0, 0, pa0); PK4(p0, 8, pa1); PK4(p1, 0, pa2); PK4(p1, 8, pa3);
#undef PK4
}
template <int DQK> __device__ __forceinline__ int k_off(int row, int chunk) { return row * (DQK * 2) + (((chunk & ~7) | ((chunk & 7) ^ ((row >> 1) & 7))) << 4); }
template <int DQK>
__device__ __forceinline__ void qkt(f32x16& p0, f32x16& p1, const __attribute__((address_space(3))) char* Kbuf, int r32, int hi, const bf16x8* qr) {
    p0 = f32x16{}; p1 = f32x16{};
    const __attribute__((address_space(3))) char* kb[4];
#pragma unroll
    for (int dd = 0; dd < 4; ++dd) kb[dd] = Kbuf + k_off<DQK>(r32, 2 * dd + hi);
#pragma unroll
    for (int d0 = 0; d0 < DQK / 16; ++d0) { const __attribute__((address_space(3))) char* a = kb[d0 & 3] + (d0 >> 2) * 128;
        bf16x8 b0 = *(const __attribute__((address_space(3))) bf16x8*)(a);
        bf16x8 b1 = *(const __attribute__((address_space(3))) bf16x8*)(a + 32 * DQK * 2);
        p0 = __builtin_amdgcn_mfma_f32_32x32x16_bf16(b0, qr[d0], p0, 0, 0, 0); p1 = __builtin_amdgcn_mfma_f32_32x32x16_bf16(b1, qr[d0], p1, 0, 0, 0);
        if ((d0 & 3) == 3) SBAR(); }
}
__device__ __forceinline__ void pv_tile(f32x16* o, int vb0, bf16x8 pa0, bf16x8 pa1, bf16x8 pa2, bf16x8 pa3) {
#define TRRD(dst, off) asm volatile("ds_read_b64_tr_b16 %0, %1 offset:%2" : "=&v"(dst) : "v"(vb0), "i"(off) : "memory")
#define PV_D0(d0) do { s16x4 l0, l1, l2, l3, h0, h1, h2, h3; constexpr int b_ = v_rd_off(d0, 0, 0); \
        TRRD(l0, b_); TRRD(h0, b_ + 2048); TRRD(l1, b_ + 4096); TRRD(h1, b_ + 6144); TRRD(l2, b_ + 8192); TRRD(h2, b_ + 10240); TRRD(l3, b_ + 12288); TRRD(h3, b_ + 14336); \
        asm volatile("s_waitcnt lgkmcnt(0)" ::: "memory"); SBAR();   \
        o[d0] = __builtin_amdgcn_mfma_f32_32x32x16_bf16(pa0, (bf16x8){l0[0], l0[1], l0[2], l0[3], h0[0], h0[1], h0[2], h0[3]}, o[d0], 0, 0, 0);   \
        o[d0] = __builtin_amdgcn_mfma_f32_32x32x16_bf16(pa1, (bf16x8){l1[0], l1[1], l1[2], l1[3], h1[0], h1[1], h1[2], h1[3]}, o[d0], 0, 0, 0);   \
        o[d0] = __builtin_amdgcn_mfma_f32_32x32x16_bf16(pa2, (bf16x8){l2[0], l2[1], l2[2], l2[3], h2[0], h2[1], h2[2], h2[3]}, o[d0], 0, 0, 0);   \
        o[d0] = __builtin_amdgcn_mfma_f32_32x32x16_bf16(pa3, (bf16x8){l3[0], l3[1], l3[2], l3[3], h3[0], h3[1], h3[2], h3[3]}, o[d0], 0, 0, 0); } while (0)
    PV_D0(0); PV_D0(1); PV_D0(2); PV_D0(3);
#undef PV_D0
#undef TRRD
}
constexpr int NBUF = 3;
template <int DQK> constexpr int lds_bytes() { return NBUF * SHM_V + NBUF * KVBLK * DQK * 2 + NW * 64 * 4; }

struct AttnOut { bf16* Ob; float* Of; int opb, opf; float lam, post; const float* gsub; };
template <int DQK, int MODE, int qp, int kp, int vp, bool PIPE>
__device__ __forceinline__ void attn_unit(const bf16* Q, const bf16* K, const bf16* V, int qb, const AttnOut& AO, char* lds, __attribute__((address_space(3))) unsigned char* ldsl) {
    constexpr int SHM_K = KVBLK * DQK * 2, NKP = SHM_K / 8192, NVP = 2, NPW = NKP + NVP, ND = DQK / 16;
    constexpr int K_BASE = NBUF * SHM_V, WS_BASE = K_BASE + NBUF * SHM_K;
    int tid_ = threadIdx.x; asm volatile("" : "+v"(tid_));
    const int tid = tid_, wid = __builtin_amdgcn_readfirstlane(tid >> 6), lane = tid & 63, r32 = lane & 31, hi = lane >> 5;
    const int q0 = qb * QB, NT = (q0 + QB) / KVBLK;
    const int qlo = q0 + wid * QBLK, qm = qlo + r32 - 4 * hi;
    __attribute__((address_space(3))) float* ws = (__attribute__((address_space(3))) float*)(ldsl + WS_BASE) + wid * 64;
    float l_reg = 0; f32x16 o[4] = {};
    unsigned kgo[NKP], vgo[NVP];
#pragma unroll
    for (int i = 0; i < NKP; ++i) { const int ob = (wid + 8 * i) * 1024 + lane * 16, row = ob / (DQK * 2), sw = (ob % (DQK * 2)) >> 4, ch = (sw & ~7) | ((sw & 7) ^ ((row >> 1) & 7));
        kgo[i] = (unsigned)(row * kp + ch * 8) * 2u; }
#pragma unroll
    for (int j = 0; j < NVP; ++j) { const int ob = (wid + 8 * j) * 1024 + lane * 16, sub = ob >> 9, within = ob & 511, kk = (sub >> 2) * 8 + (within >> 6), c = (sub & 3) * 32 + ((within & 63) >> 1);
        const int k = (kk & ~0xC) | ((kk & 4) << 1) | ((kk & 8) >> 1);
        vgo[j] = (unsigned)(k * vp + c) * 2u; }
    const int vb0 = (int)(uintptr_t)lds + v_rd_base(lane);
#define DMA_TILE(t, b) do { const char* Kt_ = (const char*)K + (size_t)(t) * (KVBLK * kp * 2); const char* Vt_ = (const char*)V + (size_t)(t) * (KVBLK * vp * 2); \
        _Pragma("unroll") for (int i_ = 0; i_ < NKP; ++i_) __builtin_amdgcn_global_load_lds((const unsigned*)(Kt_ + kgo[i_]), (__attribute__((address_space(3))) unsigned*)(ldsl + K_BASE + (b) * SHM_K + (wid + 8 * i_) * 1024), 16, 0, 0); \
        _Pragma("unroll") for (int j_ = 0; j_ < NVP; ++j_) __builtin_amdgcn_global_load_lds((const unsigned*)(Vt_ + vgo[j_]), (__attribute__((address_space(3))) unsigned*)(ldsl + (b) * SHM_V + (wid + 8 * j_) * 1024), 16, 0, 0); } while (0)
#define MASKT(P0_, P1_, t) do { const int kb_ = (t) * KVBLK; if (kb_ + KVBLK - 1 > qlo) mask_tile(P0_, P1_, qm - kb_); } while (0)
    bf16x8 qr[ND];
#pragma unroll
    for (int d0 = 0; d0 < ND; ++d0) qr[d0] = *(const bf16x8*)(Q + (size_t)(qlo + r32) * qp + d0 * 16 + hi * 8);
    DMA_TILE(0, 0); DMA_TILE(1, 1);
    asm volatile("s_waitcnt vmcnt(0)\n\ts_barrier" ::: "memory");
    bf16x8 pa0, pa1, pa2, pa3;
#define ABAR() asm volatile("s_waitcnt lgkmcnt(0)\n\ts_barrier" ::: "memory")
#define VMW_BAR(n) asm volatile("s_waitcnt vmcnt(%0) lgkmcnt(0)\n\ts_barrier" :: "n"(n) : "memory")
    f32x16 pA0, pA1, pB0, pB1;
    int bc = 0, bk = 1, bn = 2;
#define ROT3() do { const int t_ = bc; bc = bk; bk = bn; bn = t_; } while (0)
#define KBUF(b) ((const __attribute__((address_space(3))) char*)ldsl + K_BASE + (b) * SHM_K)
#define STEP(PX0, PX1, PY0, PY1, t) do {                                                      \
        if ((t) + 2 < NT) DMA_TILE((t) + 2, bn);                                               \
        SBAR(); qkt<DQK>(PX0, PX1, KBUF(bk), r32, hi, qr);                                      \
        finishSM(PY0, PY1, l_reg, pa0, pa1, pa2, pa3); SBAR();                                  \
        pv_tile(o, vb0 + bc * SHM_V, pa0, pa1, pa2, pa3);                                      \
        MASKT(PX0, PX1, (t) + 1); expA(PX0);                                                   \
        VMW_BAR(0); ROT3(); } while (0)
    if constexpr (PIPE) {
    qkt<DQK>(pA0, pA1, KBUF(0), r32, hi, qr);
    MASKT(pA0, pA1, 0); expA(pA0);
    for (int t = 0; t + 2 < NT; t += 2) {
        STEP(pB0, pB1, pA0, pA1, t);
        STEP(pA0, pA1, pB0, pB1, t + 1);
    }
    STEP(pB0, pB1, pA0, pA1, NT - 2);
    finishSM(pB0, pB1, l_reg, pa0, pa1, pa2, pa3); SBAR();
    pv_tile(o, vb0 + bc * SHM_V, pa0, pa1, pa2, pa3);
    } else {
    for (int t = 0; t < NT; ++t) {
        if (t + 2 < NT) DMA_TILE(t + 2, bn);
        qkt<DQK>(pA0, pA1, KBUF(bc), r32, hi, qr);
        MASKT(pA0, pA1, t); expA(pA0);
        finishSM(pA0, pA1, l_reg, pa0, pa1, pa2, pa3); SBAR();
        pv_tile(o, vb0 + bc * SHM_V, pa0, pa1, pa2, pa3);
        if (t + 2 < NT) VMW_BAR(NPW); else VMW_BAR(0);
        ROT3();
    }
    }
    { auto rr = __builtin_amdgcn_permlane32_swap(__float_as_uint(l_reg), __float_as_uint(l_reg), false, false); l_reg = __uint_as_float(rr[0]) + __uint_as_float(rr[1]); }
    if (hi == 0) ws[r32] = l_reg;
    asm volatile("s_waitcnt lgkmcnt(0)" ::: "memory");
    float rli[16];
#pragma unroll
    for (int r = 0; r < 16; ++r) rli[r] = __builtin_amdgcn_rcpf(ws[crow(r, hi)]);
    asm volatile("s_waitcnt lgkmcnt(0)\n\ts_barrier" ::: "memory");
    __attribute__((address_space(3))) unsigned short* stg = (__attribute__((address_space(3))) unsigned short*)(ldsl + wid * 8192);
#define STORE_STAGED(Ow_, pitch_) do { asm volatile("s_waitcnt lgkmcnt(0)" ::: "memory"); \
        _Pragma("unroll") for (int i_ = 0; i_ < 8; ++i_) { const int rw_ = i_ * 4 + (lane >> 4), ch_ = lane & 15; \
            const u32x4 v_ = *(const __attribute__((address_space(3))) u32x4*)(stg + rw_ * 128 + ch_ * 8); *(u32x4*)((Ow_) + (size_t)rw_ * (pitch_) + ch_ * 8) = v_; } } while (0)
    if constexpr (MODE == 0) {
        bf16* Ow = AO.Ob + (size_t)qlo * AO.opb;
#pragma unroll
        for (int r = 0; r < 16; ++r) { const int orow = crow(r, hi);
#pragma unroll
            for (int d0 = 0; d0 < 4; ++d0) { const float v = o[d0][r] * rli[r]; stg[orow * 128 + d0 * 32 + r32] = (unsigned short)(cvtpk(v, v) & 0xffffu); } }
        STORE_STAGED(Ow, AO.opb);
    } else if constexpr (MODE == 1) {
        u32x4* Ow = (u32x4*)AO.Of + (size_t)wid * 512 + lane;
#pragma unroll
        for (int jj = 0; jj < 8; ++jj) { const int r4 = (jj >> 1) * 4, da = (jj & 1) * 2, db = da + 1; u32x4 w;
            w.x = cvtpk(o[da][r4] * rli[r4], o[da][r4 + 1] * rli[r4 + 1]); w.y = cvtpk(o[da][r4 + 2] * rli[r4 + 2], o[da][r4 + 3] * rli[r4 + 3]);
            w.z = cvtpk(o[db][r4] * rli[r4], o[db][r4 + 1] * rli[r4 + 1]); w.w = cvtpk(o[db][r4 + 2] * rli[r4 + 2], o[db][r4 + 3] * rli[r4 + 3]);
            Ow[jj * 64] = w; }
    } else {
        const u32x4* O1 = (const u32x4*)AO.Of + (size_t)wid * 512 + lane; bf16* Ow = AO.Ob + (size_t)qlo * AO.opb;
        f32x4 o1v[16];
#pragma unroll
        for (int jj = 0; jj < 8; ++jj) { const u32x4 w = O1[jj * 64]; const int j0 = (jj >> 1) * 4 + (jj & 1) * 2;
            o1v[j0] = (f32x4){__builtin_bit_cast(float, w.x << 16), __builtin_bit_cast(float, w.x & 0xffff0000u), __builtin_bit_cast(float, w.y << 16), __builtin_bit_cast(float, w.y & 0xffff0000u)};
            o1v[j0 + 1] = (f32x4){__builtin_bit_cast(float, w.z << 16), __builtin_bit_cast(float, w.z & 0xffff0000u), __builtin_bit_cast(float, w.w << 16), __builtin_bit_cast(float, w.w & 0xffff0000u)}; }
        float gs[4];
#pragma unroll
        for (int d0 = 0; d0 < 4; ++d0) gs[d0] = AO.gsub[d0 * 32 + r32] * AO.post;
#pragma unroll
        for (int r = 0; r < 16; ++r) { const int orow = crow(r, hi); float v[4]; float q = 0.f;
#pragma unroll
            for (int d0 = 0; d0 < 4; ++d0) { v[d0] = o1v[(r >> 2) * 4 + d0][r & 3] - AO.lam * (o[d0][r] * rli[r]); q += v[d0] * v[d0]; }
            q += __shfl_xor(q, 1); q += __shfl_xor(q, 2); q += __shfl_xor(q, 4); q += __shfl_xor(q, 8); q += __shfl_xor(q, 16);
            const float rs = 1.0f / sqrtf(q * (1.0f / 128.0f) + EPS);
#pragma unroll
            for (int d0 = 0; d0 < 4; ++d0) { const float y = v[d0] * rs * gs[d0]; stg[orow * 128 + d0 * 32 + r32] = (unsigned short)(cvtpk(y, y) & 0xffffu); } }
        STORE_STAGED(Ow, AO.opb);
    }
#undef STORE_STAGED
    asm volatile("s_waitcnt vmcnt(0) lgkmcnt(0)\n\ts_barrier" ::: "memory");
#undef DMA_TILE
#undef MASKT
#undef ABAR
#undef VMW_BAR
#undef ROT3
#undef KBUF
#undef STEP
}
#undef SBAR
}

#define GAS __attribute__((address_space(1)))
#define LAS __attribute__((address_space(3)))
typedef unsigned short bf16;
typedef unsigned v4u __attribute__((ext_vector_type(4)));
typedef float f32x4 __attribute__((ext_vector_type(4)));
typedef GAS unsigned gu32;
#define RLX_AGENT __ATOMIC_RELAXED, __HIP_MEMORY_SCOPE_AGENT
#define LDS_WAIT() asm volatile("s_waitcnt lgkmcnt(0)" ::: "memory")
__device__ __forceinline__ unsigned f2bf(float f) { unsigned u = __builtin_bit_cast(unsigned, f); return (u + 0x7fffu + ((u >> 16) & 1u)) >> 16; }
__device__ __forceinline__ unsigned pk2(float lo, float hi) { return f2bf(lo) | (f2bf(hi) << 16); }
__device__ __forceinline__ float bf2f(unsigned short b) { return __builtin_bit_cast(float, (unsigned)b << 16); }
__device__ __forceinline__ void unpack8(v4u w, float* v) {
    v[0] = __builtin_bit_cast(float, w.x << 16); v[1] = __builtin_bit_cast(float, w.x & 0xffff0000u); v[2] = __builtin_bit_cast(float, w.y << 16); v[3] = __builtin_bit_cast(float, w.y & 0xffff0000u);
    v[4] = __builtin_bit_cast(float, w.z << 16); v[5] = __builtin_bit_cast(float, w.z & 0xffff0000u); v[6] = __builtin_bit_cast(float, w.w << 16); v[7] = __builtin_bit_cast(float, w.w & 0xffff0000u);
}
__device__ __forceinline__ v4u pack8v(const float* v) { v4u w; w.x = pk2(v[0], v[1]); w.y = pk2(v[2], v[3]); w.z = pk2(v[4], v[5]); w.w = pk2(v[6], v[7]); return w; }

#define XB_TMO      128
#define XB_XCNT(j)  (256  + 64 * (j))
#define XB_XSUB(j)  (1280 + 64 * (j))
#define XB_XGEN(j)  (2304 + 64 * (j))
#define XB_TOP      3328
#define XB_TOPGEN   3392
#define XCD_BAR_WORDS 3456
#define XB_SPIN_CAP (1u << 18)
__device__ __forceinline__ unsigned xb_ld(unsigned* p)              { return __hip_atomic_load(p, __ATOMIC_RELAXED, __HIP_MEMORY_SCOPE_AGENT); }
__device__ __forceinline__ unsigned xb_add(unsigned* p, unsigned v) { return __hip_atomic_fetch_add(p, v, __ATOMIC_RELAXED, __HIP_MEMORY_SCOPE_AGENT); }
__device__ __forceinline__ unsigned xb_xcc_id() { return (unsigned)__builtin_amdgcn_s_getreg((3 << 11) | 20) & 0xFu; }
#define XB_SPIN(cond, bar) do { unsigned _sp = 0; while (cond) { __builtin_amdgcn_s_sleep(1); \
    if ((++_sp & 255u) == 0u) { if (xb_ld(&(bar)[XB_TMO])) break; if (_sp > XB_SPIN_CAP) { atomicAdd(&(bar)[XB_TMO], 1u); break; } } } } while (0)
struct XcdBarrier { unsigned* bar; unsigned x; volatile LAS unsigned* st; };
__device__ __forceinline__ XcdBarrier xcd_barrier_post(unsigned* bar, volatile LAS unsigned* st) {
    XcdBarrier b; b.bar = bar; b.x = xb_xcc_id(); b.st = st;
    if (threadIdx.x == 0) (void)xb_add(&bar[XB_XCNT(b.x)], 1u);
    return b;
}
__device__ __forceinline__ void xcd_barrier_complete(unsigned* bar, unsigned x, unsigned& nloc, unsigned& nx) {
    const unsigned G = gridDim.x * gridDim.y * gridDim.z;
    unsigned sum, cnt, mine, sp = 0u;
    for (;;) {
        sum = 0u; cnt = 0u; mine = 0u;
#pragma unroll
        for (unsigned j = 0; j < 16; ++j) { const unsigned c = xb_ld(&bar[XB_XCNT(j)]); sum += c; cnt += (c > 0u) ? 1u : 0u; mine = (j == x) ? c : mine; }
        if (sum == G) break;
        __builtin_amdgcn_s_sleep(1);
        if ((++sp & 255u) == 0u) { if (xb_ld(&bar[XB_TMO])) break; if (sp > XB_SPIN_CAP) { atomicAdd(&bar[XB_TMO], 1u); break; } }
    }
    nloc = mine > 0u ? mine : 1u; nx = cnt > 0u ? cnt : 1u;
}
__device__ __forceinline__ void xcd_barrier(const XcdBarrier& b) {
    asm volatile("s_waitcnt vmcnt(0)" ::: "memory");
    __syncthreads();
    if (threadIdx.x == 0) {
        unsigned* bar = b.bar;
        __builtin_amdgcn_s_waitcnt(0);
        unsigned nloc = b.st[0], nx = b.st[1];
        if (nloc == 0u) { xcd_barrier_complete(bar, b.x, nloc, nx); b.st[0] = nloc; b.st[1] = nx; }
        const unsigned old = xb_add(&bar[XB_XSUB(b.x)], 1u);
        const unsigned gen = old / nloc;
        if (old + 1u == (gen + 1u) * nloc) {
            __builtin_amdgcn_fence(__ATOMIC_RELEASE, "agent");
            asm volatile("s_waitcnt vmcnt(0)" ::: "memory");
            const unsigned og = xb_add(&bar[XB_TOP], 1u);
            const unsigned tg = og / nx;
            if (og + 1u == (tg + 1u) * nx) xb_add(&bar[XB_TOPGEN], 1u);
            else XB_SPIN(xb_ld(&bar[XB_TOPGEN]) == tg, bar);
            __builtin_amdgcn_fence(__ATOMIC_ACQUIRE, "agent");
            xb_add(&bar[XB_XGEN(b.x)], 1u);
            asm volatile("s_waitcnt vmcnt(0)" ::: "memory");
        } else {
            XB_SPIN(xb_ld(&bar[XB_XGEN(b.x)]) == gen, bar);
            __builtin_amdgcn_fence(__ATOMIC_ACQUIRE, "agent");
            asm volatile("s_waitcnt vmcnt(0)" ::: "memory");
        }
    }
    __syncthreads();
}

struct Args {
    const float* in[21]; float* out; unsigned char* ws; int ph_lo, ph_hi;
};
__device__ __forceinline__ float wave_sum(float v) {
#pragma unroll
    for (int o = 1; o < 64; o <<= 1) v += __shfl_xor(v, o);
    return v;
}
__device__ __forceinline__ void sincos_rev(float ang, float& s, float& c) {
    double r = (double)ang * 0.15915494309189533577; r -= __builtin_rint(r); const float f = (float)r;
    s = __builtin_amdgcn_sinf(f); c = __builtin_amdgcn_cosf(f);
}
__device__ __forceinline__ int rowmap(int mode, int n) {
    if (mode == 0) return n;
    if (mode == 1) return (n / 128) * 256 + (n % 128);
    if (mode == 2) return (n / 128) * 256 + 128 + (n % 128);
    if (mode == 5) return (n >> 8) * 128 + (n & 127);
    if (mode == 3) { const int h = n / 192, d = n % 192; return h * 256 + (d < 128 ? d : 128 + 2 * ((d - 128) & 31) + ((d - 128) >> 5)); }
    return n < 1920 ? n : 1920 + 2 * ((n - 1920) & 31) + ((n - 1920) >> 5);
}
__device__ __forceinline__ void tr_item(const float* W, int K, int N, bf16* WT, const float* gain, int mode, LAS float* scr, int item, int lane, int f8 = 0) {
    const int nblk = N / 32, kb = item / nblk, nb = item % nblk, k0 = 64 * kb, n0 = 32 * nb;
    float wv[32];
#pragma unroll
    for (int i = 0; i < 32; ++i) wv[i] = __builtin_nontemporal_load(W + (size_t)(k0 + 2 * i + (lane >> 5)) * N + n0 + (lane & 31));
    if (gain) {
#pragma unroll
        for (int i = 0; i < 32; ++i) wv[i] *= gain[k0 + 2 * i + (lane >> 5)]; }
#pragma unroll
    for (int i = 0; i < 32; ++i) scr[(2 * i + (lane >> 5)) * 33 + (lane & 31)] = wv[i];
    LDS_WAIT(); asm volatile("" ::: "memory");
    const int c = lane & 7;
#pragma unroll
    for (int j = 0; j < 4; ++j) { const int n = (lane >> 3) + 8 * j; const LAS float* s = scr + (8 * c) * 33 + n;
        if (f8 == 2) { unsigned long long q = 0ull;
#pragma unroll
            for (int e = 0; e < 8; ++e) { int v = (int)__builtin_rintf(s[e * 33] * WQ_I8); v = v < -127 ? -127 : (v > 127 ? 127 : v); q |= (unsigned long long)(unsigned)(v & 255) << (8 * e); }
            *(GAS unsigned long long*)((unsigned char*)WT + (size_t)rowmap(mode, n0 + n) * K + k0 + 8 * c) = q; }
        else if (f8) { int w0 = __builtin_amdgcn_cvt_pk_fp8_f32(s[0 * 33] * 64.0f, s[1 * 33] * 64.0f, 0, false); w0 = __builtin_amdgcn_cvt_pk_fp8_f32(s[2 * 33] * 64.0f, s[3 * 33] * 64.0f, w0, true);
            int w1 = __builtin_amdgcn_cvt_pk_fp8_f32(s[4 * 33] * 64.0f, s[5 * 33] * 64.0f, 0, false); w1 = __builtin_amdgcn_cvt_pk_fp8_f32(s[6 * 33] * 64.0f, s[7 * 33] * 64.0f, w1, true);
            *(GAS unsigned long long*)((unsigned char*)WT + (size_t)rowmap(mode, n0 + n) * K + k0 + 8 * c) = (unsigned long long)(unsigned)w0 | ((unsigned long long)(unsigned)w1 << 32); }
        else { v4u o; o.x = pk2(s[0 * 33], s[1 * 33]); o.y = pk2(s[2 * 33], s[3 * 33]); o.z = pk2(s[4 * 33], s[5 * 33]); o.w = pk2(s[6 * 33], s[7 * 33]);
        *(GAS v4u*)(WT + (size_t)rowmap(mode, n0 + n) * K + k0 + 8 * c) = o; } }
    LDS_WAIT(); asm volatile("" ::: "memory");
}

__device__ __forceinline__ void quant_rows(const bf16* X, unsigned char* X8, const float* ss, float* rsq, int w0, int nw, int lane) {
    for (int m0 = w0; m0 < M; m0 += 2 * nw) {
        v4u xw[2][2]; float sq[2];
#pragma unroll
        for (int u = 0; u < 2; ++u) { const int m = (m0 + u * nw) < M ? m0 + u * nw : m0;
            xw[u][0] = *(const GAS v4u*)(X + (size_t)m * DM + lane * 8); xw[u][1] = *(const GAS v4u*)(X + (size_t)m * DM + 512 + lane * 8);
            sq[u] = lane < 16 ? ss[(size_t)m * 16 + lane] : 0.f; }
#pragma unroll
        for (int u = 0; u < 2; ++u) { const int m = m0 + u * nw; if (m < M) {
            float x[16]; unpack8(xw[u][0], x); unpack8(xw[u][1], x + 8);
            float am = 0.f;
#pragma unroll
            for (int i = 0; i < 16; ++i) am = fmaxf(am, fabsf(x[i]));
#pragma unroll
            for (int o = 1; o < 64; o <<= 1) am = fmaxf(am, __shfl_xor(am, o));
            const float inv = am > 0.f ? 127.0f / am : 0.f;
            unsigned long long q0 = 0ull, q1 = 0ull;
#pragma unroll
            for (int e = 0; e < 8; ++e) { const int a = (int)__builtin_rintf(x[e] * inv), b = (int)__builtin_rintf(x[8 + e] * inv);
                q0 |= (unsigned long long)(unsigned)(a & 255) << (8 * e); q1 |= (unsigned long long)(unsigned)(b & 255) << (8 * e); }
            *(GAS unsigned long long*)(X8 + (size_t)m * DM + lane * 8) = q0; *(GAS unsigned long long*)(X8 + (size_t)m * DM + 512 + lane * 8) = q1;
            const float sqs = wave_sum(sq[u]);
            if (lane == 0) rsq[m] = (1.0f / sqrtf(sqs * (1.0f / 1024.0f) + EPS)) * (am * (1.0f / 127.0f)); } }
    }
}

__device__ __forceinline__ void absorb_item(const float* Wukv, const float* Wo, bf16* WT, LAS float* scr, int item, int lane) {
    const int ig = item & 3, nb = (item >> 2) & 31, jb = (item >> 7) & 1, h = item >> 8;
    const int j0 = 64 * jb + 16 * ig, n0 = 32 * nb, n = lane & 31, half = lane >> 5;
    float acc[8] = {0.f, 0.f, 0.f, 0.f, 0.f, 0.f, 0.f, 0.f};
    const float* ap = Wukv + (size_t)(j0 + half) * 1024 + h * 256 + 128;
    const float* bp = Wo + (size_t)(512 + 128 * h) * DM + n0 + n;
#pragma unroll 2
    for (int d4 = 0; d4 < 32; ++d4) {
        const float b0 = bp[(size_t)(4 * d4 + 0) * DM], b1 = bp[(size_t)(4 * d4 + 1) * DM], b2 = bp[(size_t)(4 * d4 + 2) * DM], b3 = bp[(size_t)(4 * d4 + 3) * DM];
#pragma unroll
        for (int i = 0; i < 8; ++i) { const f32x4 a4 = *(const GAS f32x4*)(ap + (size_t)(2 * i) * 1024 + 4 * d4); acc[i] += (a4.x * b0 + a4.y * b1) + (a4.z * b2 + a4.w * b3); }
    }
#pragma unroll
    for (int i = 0; i < 8; ++i) scr[(2 * i + half) * 33 + n] = acc[i];
    LDS_WAIT(); asm volatile("" ::: "memory");
    { const int n2 = lane >> 1, kh = lane & 1; const LAS float* sp = scr + (8 * kh) * 33 + n2;
      v4u o; o.x = pk2(sp[0 * 33], sp[1 * 33]); o.y = pk2(sp[2 * 33], sp[3 * 33]); o.z = pk2(sp[4 * 33], sp[5 * 33]); o.w = pk2(sp[6 * 33], sp[7 * 33]);
      *(GAS v4u*)(WT + (size_t)(n0 + n2) * DM + 512 + 128 * h + j0 + 8 * kh) = o; }
    LDS_WAIT(); asm volatile("" ::: "memory");
}

__global__ void __launch_bounds__(NWAVES * 64, 2) fwd_kernel(Args args) {
    extern __shared__ __attribute__((aligned(16))) unsigned char lds[];
    LAS unsigned char* ldsl = (LAS unsigned char*)lds;
    const int tid0 = threadIdx.x, wave = __builtin_amdgcn_readfirstlane(tid0 >> 6);
    const int G0 = gridDim.x; const int bx0 = blockIdx.x; const int vcu0 = (G0 % 8 == 0) ? (bx0 % 8) * (G0 / 8) + bx0 / 8 : bx0;
    unsigned char* ws0 = args.ws;
    gu32* ctl = (gu32*)(ws0 + WS_CTL);
    for (int u = tid0; u < (LDS_BYTES - LDSCTL_OFF) / 4; u += NWAVES * 64) ((LAS unsigned*)(ldsl + LDSCTL_OFF))[u] = 0u;
    __syncthreads();
    XcdBarrier bar; bar.bar = (unsigned*)(ctl + CW_BAR); bar.x = 0; bar.st = nullptr;
    if (!MK_PER_PHASE) bar = xcd_barrier_post((unsigned*)(ctl + CW_BAR), (volatile LAS unsigned*)(ldsl + MISC_OFF) + 8);
    const int lo = args.ph_lo, hi = args.ph_hi;
#define IN(k) (lo <= (k) && (k) < hi)
#define GRIDBAR() do { XcdBarrier b_ = bar; GAS unsigned* bb_ = (GAS unsigned*)b_.bar; asm volatile("" : "+s"(bb_)); b_.bar = (unsigned*)bb_; xcd_barrier(b_); if (DUP_BAR) xcd_barrier(b_); } while (0)
#define SEAM(k) do { if (!MK_PER_PHASE && IN(k) && IN((k) + 1)) GRIDBAR(); } while (0)
#define RFL(x) __builtin_amdgcn_readfirstlane(x)
#define gw (vcu * NWAVES + wave)
#define NGW (G * NWAVES)
#define PHASE_WS() GAS unsigned char* wsg_ = (GAS unsigned char*)ws0; asm volatile("" : "+s"(wsg_)); unsigned char* ws = (unsigned char*)wsg_; int G = G0, bx = bx0, vcu = vcu0; asm volatile("" : "+s"(G), "+s"(bx), "+s"(vcu)); (void)G; (void)bx; (void)vcu; int tid = tid0; asm volatile("" : "+v"(tid)); const int lane = tid & 63; (void)lane; auto ka_ = __builtin_amdgcn_kernarg_segment_ptr(); asm volatile("" : "+s"(ka_)); const GAS float* const __attribute__((address_space(4)))* INP = (const GAS float* const __attribute__((address_space(4)))*)ka_
#define SS ((float*)(ws + WS_SS))
#define ROPD ((float*)(ws + WS_ROPD))
#define ROPM ((float*)(ws + WS_ROPM))
#define MISCF ((float*)(ws + WS_MISC))
#define MISCI ((int*)(ws + WS_MISC))
#define XB ((bf16*)(ws + WS_XB))
#define AOB ((bf16*)(ws + WS_AO))
#define QM ((bf16*)(ws + WS_QM))
#define KVU ((bf16*)(ws + WS_KVU))
#define KM ((bf16*)(ws + WS_KM))
#define VM ((bf16*)(ws + WS_KVU))
#define KPR ((bf16*)(ws + WS_KVU + 32 * MiB))
#define KPESS ((float*)(ws + WS_KPESS))
#define CQN (l == 0 ? (bf16*)(ws + 457 * MiB) : (bf16*)((unsigned char*)outp + 64 * MiB))
#define CKVN (CQN + (size_t)M * MQR)
#define OD1 (l == 0 ? (float*)(ws + 393 * MiB) : outp)
#define WBL ((const bf16*)(ws + (l == 0 ? WS_W0 : WS_W1)))
#define PROJ (l == 0 ? (bf16*)outp : (bf16*)(ws + WS_PROJ1))
#define INPF(k) ((const float*)INP[k])
#define x_in INPF(0)
#define XG8 ((unsigned char*)outp + 32 * MiB)
#define XB8A ((unsigned char*)(ws + WS_AO))
#define XB8 ((unsigned char*)outp)
    float* outp = args.out;

    if (PH_ON(11) && IN(0)) for (int rep_ = 0; rep_ < REP(11); ++rep_) { PHASE_WS();
        LAS float* scr = (LAS float*)(ldsl + wave * 16384);
        constexpr int I_IN = 16 * 62, I_UQ = 4 * 24, I_UKV = 2 * 32, I_O = 16 * 32, I_AB = 4 * 2 * 32 * 4, I_L = I_IN + I_UQ + I_UKV + I_O + I_AB;
        constexpr int I_DG = 16 * 88, I_DD = 44 * 32, I_ME = 16 * 44, I_MD = 22 * 32;
        constexpr int NITEMS = 2 * I_L + 2 * I_DG + I_DD + 8 * (2 * I_ME + I_MD);
        for (int it = gw; it < NITEMS; it += NGW) {
            int r = it;
            if (r < 2 * I_L) { const int l = r / I_L; r -= l * I_L; bf16* wb = (bf16*)(ws + (l == 0 ? WS_W0 : WS_W1));
                if (r < I_IN) { tr_item(INPF(2) + (size_t)l * DM * INC, DM, INC, (bf16*)((char*)wb + WOFF_IN), INPF(1) + l * DM, 4, scr, r, lane, I8_IN ? 2 : 0); continue; } r -= I_IN;
                if (r < I_UQ) { tr_item(INPF(8) + (size_t)l * MQR * 768, MQR, 768, (bf16*)((char*)wb + WOFF_UQ), nullptr, 3, scr, r, lane); continue; } r -= I_UQ;
                if (r < I_UKV) { if (((r & 31) & 7) < 4) tr_item(INPF(10) + (size_t)l * MKR * 1024, MKR, 1024, (bf16*)((char*)wb + WOFF_UKV), nullptr, 5, scr, r, lane); continue; } r -= I_UKV;
                if (r < I_AB) { absorb_item(INPF(10) + (size_t)l * MKR * 1024, INPF(12) + (size_t)l * DM * DM, (bf16*)((char*)wb + WOFF_O), scr, r, lane); continue; } r -= I_AB;
                if (r < 8 * 32) tr_item(INPF(12) + (size_t)l * DM * DM, DM, DM, (bf16*)((char*)wb + WOFF_O), nullptr, 0, scr, r, lane);
                continue; }
            r -= 2 * I_L;
            if (r < I_DG) { tr_item(INPF(14), DM, DFF, (bf16*)(ws + WS_W0 + WOFF_GU), INPF(13), 1, scr, r, lane, FP8_GU); continue; } r -= I_DG;
            if (r < I_DG) { tr_item(INPF(15), DM, DFF, (bf16*)(ws + WS_W0 + WOFF_GU), INPF(13), 2, scr, r, lane, FP8_GU); continue; } r -= I_DG;
            if (r < I_DD) { tr_item(INPF(16), DFF, DM, (bf16*)(ws + WS_W0 + WOFF_D), nullptr, 0, scr, r, lane); continue; } r -= I_DD;
            if (r < 8 * I_ME) { const int e = r / I_ME; r -= e * I_ME; tr_item(INPF(18) + (size_t)e * DM * DFFE, DM, DFFE, I8_MOE ? (bf16*)(ws + WS_WMOE_GU + (size_t)e * 2816 * DM) : (bf16*)(ws + WS_WMOE_GU) + (size_t)e * 2816 * DM, INPF(13) + DM, 1, scr, r, lane, I8_MOE ? 2 : 0); continue; } r -= 8 * I_ME;
            if (r < 8 * I_ME) { const int e = r / I_ME; r -= e * I_ME; tr_item(INPF(19) + (size_t)e * DM * DFFE, DM, DFFE, I8_MOE ? (bf16*)(ws + WS_WMOE_GU + (size_t)e * 2816 * DM) : (bf16*)(ws + WS_WMOE_GU) + (size_t)e * 2816 * DM, INPF(13) + DM, 2, scr, r, lane, I8_MOE ? 2 : 0); continue; } r -= 8 * I_ME;
            { const int e = r / I_MD; r -= e * I_MD; tr_item(INPF(20) + (size_t)e * DFFE * DM, DFFE, DM, (bf16*)(ws + WS_WMOE_D) + (size_t)e * DM * DFFE, nullptr, 0, scr, r, lane); }
        }
        for (int i = gw * 64 + lane; i < 2 * 64 * 128; i += NGW * 64) { const int l = i / (64 * 128), rr = (i / 128) % 64, ch = i % 128;
            if (I8_IN) { if (ch < 64) *(GAS v4u*)(ws + (l == 0 ? WS_W0 : WS_W1) + WOFF_IN + (size_t)(INC + rr) * DM + ch * 16) = (v4u){0u, 0u, 0u, 0u}; }
            else *(GAS v4u*)((bf16*)(ws + (l == 0 ? WS_W0 : WS_W1) + WOFF_IN) + (size_t)(INC + rr) * DM + ch * 8) = (v4u){0u, 0u, 0u, 0u}; }
        for (int i = gw * 64 + lane; i < 2 * 4 * 64 * 32; i += NGW * 64) { const int l = i / (4 * 64 * 32), h = (i / (64 * 32)) & 3, rr = (i / 32) & 63, ch = i & 31;
            *(GAS v4u*)((bf16*)(ws + (l == 0 ? WS_W0 : WS_W1) + WOFF_UQ) + (size_t)(h * 256 + 192 + rr) * MQR + ch * 8) = (v4u){0u, 0u, 0u, 0u}; }
        for (int m = gw; m < M; m += NGW) {
            const GAS f32x4* xr = (const GAS f32x4*)(x_in + (size_t)m * DM) + lane; f32x4 v[4]; float s = 0.f;
#pragma unroll
            for (int j = 0; j < 4; ++j) { v[j] = __builtin_nontemporal_load(xr + 64 * j); s += (v[j].x * v[j].x + v[j].y * v[j].y) + (v[j].z * v[j].z + v[j].w * v[j].w); }
            s = wave_sum(s);
            GAS unsigned long long* o8 = (GAS unsigned long long*)(XB + (size_t)m * DM) + lane;
#pragma unroll
            for (int j = 0; j < 4; ++j) o8[64 * j] = (unsigned long long)pk2(v[j].x, v[j].y) | ((unsigned long long)pk2(v[j].z, v[j].w) << 32);
            if (lane < 16) SS[(size_t)m * 16 + lane] = lane == 0 ? s : 0.f;
            if (I8_IN) { float am = 0.f;
#pragma unroll
                for (int j = 0; j < 4; ++j) am = fmaxf(fmaxf(am, fmaxf(fabsf(v[j].x), fabsf(v[j].y))), fmaxf(fabsf(v[j].z), fabsf(v[j].w)));
#pragma unroll
                for (int o = 1; o < 64; o <<= 1) am = fmaxf(am, __shfl_xor(am, o));
                const float inv = am > 0.f ? 127.0f / am : 0.f;
                GAS unsigned* q8 = (GAS unsigned*)(XB8A + (size_t)m * DM) + lane;
#pragma unroll
                for (int j = 0; j < 4; ++j) q8[64 * j] = (unsigned)((int)__builtin_rintf(v[j].x * inv) & 255) | ((unsigned)((int)__builtin_rintf(v[j].y * inv) & 255) << 8) | ((unsigned)((int)__builtin_rintf(v[j].z * inv) & 255) << 16) | ((unsigned)((int)__builtin_rintf(v[j].w * inv) & 255) << 24);
                if (lane == 0) ((float*)(ws + WS_RS))[m] = (1.0f / sqrtf(s * (1.0f / 1024.0f) + EPS)) * (am * (1.0f / 127.0f)); }
        }
        for (int i = gw * 64 + lane; i < SEQ * 8; i += NGW * 64) { const int pos = i >> 3, k = i & 7;
            const float invf = 1.0f / powf(500000.0f, (float)k * (2.0f / 16.0f)); float s, c; sincos_rev((float)pos * invf, s, c);
            ROPD[pos * 16 + k] = c; ROPD[pos * 16 + 8 + k] = s; }
        for (int i = gw * 64 + lane; i < SEQ * 32; i += NGW * 64) { const int pos = i >> 5, k = i & 31;
            const float invf = 1.0f / powf(10000.0f, (float)k * (2.0f / 64.0f)); float s, c; sincos_rev((float)pos * invf, s, c);
            ROPM[pos * 64 + k] = c; ROPM[pos * 64 + 32 + k] = s; }
        for (int i = gw * 64 + lane; i < DM * NEXP; i += NGW * 64) ((float*)(ws + WS_RW))[i] = INPF(17)[i] * INPF(13)[DM + (i >> 3)];
        for (int i = gw * 64 + lane; i < DEPTH * GT_L; i += NGW * 64) { const int l = i / GT_L, j = i % GT_L; float v;
            if (j < 64) v = INPF(3)[l * 64 + j]; else if (j < 128) v = INPF(4)[l * 64 + j - 64]; else if (j < 384) v = INPF(7)[l * 256 + j - 128]; else if (j < 512) v = INPF(9)[l * 128 + j - 384];
            else if (j < 896) v = INPF(11)[l * 384 + j - 512]; else v = INPF(6)[l * 128 + j - 896];
            MISCF[MI_GT + i] = v; }
        if (gw < DEPTH) { const int l = gw;
            const float* lp = INPF(5) + l * 256; const float a = wave_sum(lp[lane] * lp[64 + lane]), b = wave_sum(lp[128 + lane] * lp[192 + lane]);
            const float lam_init = 0.8f - 0.6f * expf(-0.3f * (float)l);
            float gq = fabsf(INPF(3)[l * 64 + lane]), gk = fabsf(INPF(4)[l * 64 + lane]);
            float mq = fmaxf(fmaxf(fabsf(INPF(11)[l * 384 + lane]), fabsf(INPF(11)[l * 384 + 64 + lane])), fabsf(INPF(11)[l * 384 + 128 + lane]));
            float mk = fmaxf(fmaxf(fabsf(INPF(11)[l * 384 + 192 + lane]), fabsf(INPF(11)[l * 384 + 256 + lane])), fabsf(INPF(11)[l * 384 + 320 + lane]));
#pragma unroll
            for (int o = 1; o < 64; o <<= 1) { gq = fmaxf(gq, __shfl_xor(gq, o)); gk = fmaxf(gk, __shfl_xor(gk, o)); mq = fmaxf(mq, __shfl_xor(mq, o)); mk = fmaxf(mk, __shfl_xor(mk, o)); }
            if (lane == 0) { MISCF[MI_LAM + l] = expf(a) - expf(b) + lam_init;
                MISCF[MI_BIASD + l] = -(0.125f * LOG2E * 64.0f * gq * gk * 1.02f); MISCF[MI_BIASM + l] = -(0.07216878364870322f * LOG2E * 192.0f * mq * mk * 1.02f); }
        }
    }
    SEAM(0);

#define SEAM2(a, b) do { if (!MK_PER_PHASE && IN(a) && IN(b)) GRIDBAR(); } while (0)
#pragma unroll 1
    for (int l = 0; l < DEPTH; ++l) {
        const int P = 1 + 10 * l;
        if (PH_ON(0) && IN(P + 0)) for (int rep_ = 0; rep_ < REP(0); ++rep_) { PHASE_WS();
#if I8_IN
            pg8::Gemm g{(const bf16*)(l == 0 ? XB8A : XB8), (const bf16*)((const char*)WBL + WOFF_IN), DM / 2, DM / 2}; pg8::StaticOrder S; S.init(M, INCP, G, bx);
            pg8::EpiInProj E{PROJ, ws, MISCF + MI_GT + l * GT_L, (LAS float*)(ldsl + PART_OFF), (const float*)(ws + WS_RS), (LAS float*)(ldsl + PART_OFF + 8192), CQN};
            pg8::gemm_phase<pg8::EpiInProj, pg8::StaticOrder, true, 2>(ldsl, g, S, E);
#else
            pg8::Gemm g{XB, (const bf16*)((const char*)WBL + WOFF_IN), DM, DM}; pg8::StaticOrder S; S.init(M, INCP, G, bx);
            pg8::EpiInProj E{PROJ, ws, MISCF + MI_GT + l * GT_L, (LAS float*)(ldsl + PART_OFF), SS, (LAS float*)(ldsl + PART_OFF + 8192), CQN};
            pg8::gemm_phase<pg8::EpiInProj, pg8::StaticOrder>(ldsl, g, S, E);
#endif
        }
        SEAM2(P + 0, P + 2);
        if (false && PH_ON(1) && IN(P + 1)) { PHASE_WS();
            const float* gq = INPF(3) + l * 64; const float* gk = INPF(4) + l * 64; const float* gqln = INPF(7) + l * MQR; const float* gkvln = INPF(9) + l * MKR;
            const int d8 = (lane & 7) * 8, sub = lane & 7;
            float gqv[8], gkv[8];
#pragma unroll
            for (int i = 0; i < 8; ++i) { gqv[i] = gq[d8 + i] * (0.125f * LOG2E); gkv[i] = gk[d8 + i]; }
            for (int m = gw; m < M; m += NGW) {
                bf16* row = PROJ + (size_t)m * INCP; const int pos = m & (SEQ - 1);
                const v4u wq = *(const GAS v4u*)(row + lane * 8), wk = *(const GAS v4u*)(row + 512 + lane * 8), wcv = *(const GAS v4u*)(row + 1536 + lane * 8);
                float cs[8], sn[8];
                { const f32x4 c0 = *(const GAS f32x4*)(ROPD + pos * 16), c1 = *(const GAS f32x4*)(ROPD + pos * 16 + 4), s0 = *(const GAS f32x4*)(ROPD + pos * 16 + 8), s1 = *(const GAS f32x4*)(ROPD + pos * 16 + 12);
#pragma unroll
                  for (int i = 0; i < 4; ++i) { cs[i] = c0[i]; cs[4 + i] = c1[i]; sn[i] = s0[i]; sn[4 + i] = s1[i]; } }
#pragma unroll
                for (int which = 0; which < 2; ++which) {
                    float v[8]; unpack8(which == 0 ? wq : wk, v); float s = 0.f;
#pragma unroll
                    for (int i = 0; i < 8; ++i) s += v[i] * v[i];
                    s += __shfl_xor(s, 1); s += __shfl_xor(s, 2); s += __shfl_xor(s, 4);
                    const float rinv = 1.0f / sqrtf(s * (1.0f / 64.0f) + EPS);
#pragma unroll
                    for (int i = 0; i < 8; ++i) v[i] *= rinv * (which == 0 ? gqv[i] : gkv[i]);
#pragma unroll
                    for (int i = 0; i < 8; ++i) { const float other = __shfl_xor(v[i], 1);
                        if (sub == 0) v[i] = v[i] * cs[i] - other * sn[i]; else if (sub == 1) v[i] = v[i] * cs[i] + other * sn[i]; }
                    *(GAS v4u*)(row + which * 512 + lane * 8) = pack8v(v);
                }
                { float v[8]; unpack8(wcv, v); float s = 0.f;
#pragma unroll
                  for (int i = 0; i < 8; ++i) s += v[i] * v[i];
                  s += __shfl_xor(s, 1); s += __shfl_xor(s, 2); s += __shfl_xor(s, 4); s += __shfl_xor(s, 8); const float s16 = s; const float s32 = s + __shfl_xor(s, 16);
                  if (lane < 32) { const float rinv = 1.0f / sqrtf(s32 * (1.0f / 256.0f) + EPS);
#pragma unroll
                      for (int i = 0; i < 8; ++i) v[i] *= rinv * gqln[lane * 8 + i];
                      *(GAS v4u*)(CQN + (size_t)m * MQR + lane * 8) = pack8v(v); }
                  else if (lane < 48) { const float rinv = 1.0f / sqrtf(s16 * (1.0f / 128.0f) + EPS);
#pragma unroll
                      for (int i = 0; i < 8; ++i) v[i] *= rinv * gkvln[(lane - 32) * 8 + i];
                      *(GAS v4u*)(CKVN + (size_t)m * MKR + (lane - 32) * 8) = pack8v(v); } }
            }
        }
        if (PH_ON(2) && IN(P + 2)) for (int rep_ = 0; rep_ < REP(2); ++rep_) { PHASE_WS();
            { pg8::Gemm g{CKVN, (const bf16*)((const char*)WBL + WOFF_UKV), MKR, MKR}; pg8::StaticOrder S; S.init(M, 512, G, bx);
              pg8::EpiMlaKV E{KM, KPR, KPESS, INPF(11) + l * 384 + 192, (LAS float*)(ldsl + PART_OFF)};
              pg8::gemm_phase<pg8::EpiMlaKV, pg8::StaticOrder>(ldsl, g, S, E); }
            { pg8::Gemm g{CQN, (const bf16*)((const char*)WBL + WOFF_UQ), MQR, MQR}; pg8::StaticOrder S; S.init(M, 1024, G, bx);
              pg8::EpiMlaQ E{QM, ROPM, INPF(11) + l * 384, (LAS float*)(ldsl + PART_OFF)};
              pg8::gemm_phase<pg8::EpiMlaQ, pg8::StaticOrder>(ldsl, g, S, E); }
        }
        SEAM2(P + 2, P + 4);
        if (false && PH_ON(3) && IN(P + 3)) { PHASE_WS();
            const float* gq = INPF(11) + l * 384; const float* gk = gq + 192;
            const int li = lane & 31, lic = li < 24 ? li : 0; const bool act = li < 24;
            float gqv[8], gkv[8];
#pragma unroll
            for (int i = 0; i < 8; ++i) { gqv[i] = gq[lic * 8 + i] * (0.07216878364870322f * LOG2E); gkv[i] = gk[lic * 8 + i]; }
            const int jb = (li & 3) * 8; const int partner = (li < 20) ? lane + 4 : lane - 4; const bool isx1 = (li >= 16 && li < 20), isx2 = (li >= 20 && li < 24);
            for (int m = gw; m < M; m += NGW) {
                const int pos = m & (SEQ - 1);
                float cs[8], sn[8];
                { const float* rp = ROPM + pos * 64 + jb; const f32x4 c0 = *(const GAS f32x4*)(rp), c1 = *(const GAS f32x4*)(rp + 4), s0 = *(const GAS f32x4*)(rp + 32), s1 = *(const GAS f32x4*)(rp + 36);
#pragma unroll
                  for (int i = 0; i < 4; ++i) { cs[i] = c0[i]; cs[4 + i] = c1[i]; sn[i] = s0[i]; sn[4 + i] = s1[i]; } }
#pragma unroll
                for (int it = 0; it < 2; ++it) {
                    const int h = 2 * it + (lane >> 5);
#pragma unroll
                    for (int which = 0; which < 2; ++which) {
                        v4u w = (v4u){0u, 0u, 0u, 0u};
                        if (act) { if (which == 0) w = *(const GAS v4u*)(QM + (size_t)m * 768 + h * 192 + li * 8);
                                   else w = (li < 16) ? *(const GAS v4u*)(KVU + (size_t)m * 1024 + h * 256 + li * 8) : *(const GAS v4u*)(PROJ + (size_t)m * INCP + 1920 + (li - 16) * 8); }
                        float v[8]; unpack8(w, v); float s = 0.f;
#pragma unroll
                        for (int i = 0; i < 8; ++i) s += v[i] * v[i];
                        s += __shfl_xor(s, 1); s += __shfl_xor(s, 2); s += __shfl_xor(s, 4); s += __shfl_xor(s, 8); s += __shfl_xor(s, 16);
                        const float rinv = 1.0f / sqrtf(s * (1.0f / 192.0f) + EPS);
#pragma unroll
                        for (int i = 0; i < 8; ++i) v[i] *= rinv * (which == 0 ? gqv[i] : gkv[i]);
#pragma unroll
                        for (int i = 0; i < 8; ++i) { const float other = __shfl(v[i], partner);
                            if (isx1) v[i] = v[i] * cs[i] - other * sn[i]; else if (isx2) v[i] = v[i] * cs[i] + other * sn[i]; }
                        if (act) { bf16* dst = (which == 0 ? QM : KM) + (size_t)m * 768 + h * 192 + li * 8; *(GAS v4u*)dst = pack8v(v); }
                    }
                }
            }
        }
        if (PH_ON(4) && IN(P + 4)) for (int rep_ = 0; rep_ < REP(4); ++rep_) { PHASE_WS();
            const float lam = MISCF[MI_LAM + l], lam_init = 0.8f - 0.6f * expf(-0.3f * (float)l);
            for (int p = vcu; p < 256; p += G) {
                const int b = p >> 5, h = (p >> 3) & 3, s = p & 7;
                const size_t r0 = (size_t)b * SEQ;
#pragma unroll 1
                for (int pass = 0; pass < 2; ++pass) {
                    const int qb = pass == 0 ? 15 - s : s;
                    att::AttnOut A1{nullptr, OD1 + (size_t)((b * 4 + h) * 16 + qb) * 16384, 0, 512, 0.f, 0.f, nullptr};
                    if (ATT_SEL & 1) att::attn_unit<64, 1, INCP, INCP, INCP, true>(PROJ + r0 * INCP + h * 128, PROJ + r0 * INCP + 512 + h * 128, PROJ + r0 * INCP + 1024 + h * 128, qb, A1, (char*)lds, ldsl);
                    att::AttnOut A2{AOB + r0 * DM + h * 128, OD1 + (size_t)((b * 4 + h) * 16 + qb) * 16384, DM, 512, lam, 1.0f - lam_init, INPF(6) + l * 128};
                    if (ATT_SEL & 2) att::attn_unit<64, 2, INCP, INCP, INCP, true>(PROJ + r0 * INCP + h * 128 + 64, PROJ + r0 * INCP + 512 + h * 128 + 64, PROJ + r0 * INCP + 1024 + h * 128, qb, A2, (char*)lds, ldsl);
                }
#pragma unroll 1
                for (int pass = 0; pass < 2; ++pass) {
                    const int qb = pass == 0 ? 15 - s : s;
                    att::AttnOut A0{AOB + r0 * DM + 512 + h * 128, nullptr, DM, 0, 0.f, 0.f, nullptr};
                    if (ATT_SEL & 4) att::attn_unit<192, 0, 768, 768, MKR, false>(QM + r0 * 768 + h * 192, KM + r0 * 768 + h * 192, CKVN + r0 * MKR, qb, A0, (char*)lds, ldsl);
                }
            }
        }
        SEAM(P + 4);
        if (PH_ON(5) && IN(P + 5)) { PHASE_WS();
            pg8::Gemm g{AOB, (const bf16*)((const char*)WBL + WOFF_O), DM, DM}; pg8::StaticOrder S; S.init(M, DM, G, bx);
            pg8::EpiResid E{XB, SS, (FP8_GU == 1 && l == 0) ? XB8 : nullptr};
            pg8::gemm_phase<pg8::EpiResid, pg8::StaticOrder>(ldsl, g, S, E);
        }
        SEAM(P + 5);
        if (l == 0) {
#define ACT0 ((bf16*)(ws + WS_ACT0))
#if FP8_GU == 2
            if (PH_ON(6) && IN(P + 6)) { PHASE_WS();
                quant_rows(XB, XB8, SS, (float*)(ws + WS_RS), gw, NGW, lane);
            }
            if (!MK_PER_PHASE && IN(P + 6)) GRIDBAR();
#endif
            if (PH_ON(6) && IN(P + 6)) for (int rep_ = 0; rep_ < REP(6); ++rep_) { PHASE_WS();
#if FP8_GU == 2
                pg8::Gemm g{(const bf16*)XB8, (const bf16*)(ws + WS_W0 + WOFF_GU), DM / 2, DM / 2}; pg8::StaticOrder S; S.init(M, 2 * DFF, G, bx);
                pg8::EpiSwiGLU E{ACT0, DFF, (const float*)(ws + WS_RS), 1, (LAS float*)(ldsl + PART_OFF + 8192), 1.0f / WQ_I8};
                pg8::gemm_phase<pg8::EpiSwiGLU, pg8::StaticOrder, true, 2>(ldsl, g, S, E);
#elif FP8_GU == 1
                pg8::Gemm g{(const bf16*)XB8, (const bf16*)(ws + WS_W0 + WOFF_GU), DM / 2, DM / 2}; pg8::StaticOrder S; S.init(M, 2 * DFF, G, bx);
                pg8::EpiSwiGLU E{ACT0, DFF, SS, 0, (LAS float*)(ldsl + PART_OFF + 8192), 1.0f / 64.0f};
                pg8::gemm_phase<pg8::EpiSwiGLU, pg8::StaticOrder, true, 1>(ldsl, g, S, E);
#else
                pg8::Gemm g{XB, (const bf16*)(ws + WS_W0 + WOFF_GU), DM, DM}; pg8::StaticOrder S; S.init(M, 2 * DFF, G, bx);
                pg8::EpiSwiGLU E{ACT0, DFF, SS, 0, (LAS float*)(ldsl + PART_OFF + 8192), 1.0f};
                pg8::gemm_phase<pg8::EpiSwiGLU, pg8::StaticOrder>(ldsl, g, S, E);
#endif
                if (PROBE_NULL_GU == 1) { pg8::EpiNull EN{(float*)(ws + WS_RS)}; pg8::gemm_phase<pg8::EpiNull, pg8::StaticOrder>(ldsl, g, S, EN); }
                if (PROBE_NULL_GU == 2) { pg8::EpiProbe<2> EN{(bf16*)(ws + 393 * MiB), DFF, SS, (float*)(ws + WS_RS)}; pg8::gemm_phase<pg8::EpiProbe<2>, pg8::StaticOrder>(ldsl, g, S, EN); }
                if (PROBE_NULL_GU == 3) { pg8::EpiProbe<3> EN{(bf16*)(ws + 393 * MiB), DFF, SS, (float*)(ws + WS_RS)}; pg8::gemm_phase<pg8::EpiProbe<3>, pg8::StaticOrder>(ldsl, g, S, EN); }
            }
            SEAM(P + 6);
            if (PH_ON(7) && IN(P + 7)) { PHASE_WS();
                pg8::Gemm g{ACT0, (const bf16*)(ws + WS_W0 + WOFF_D), DFF, DFF}; pg8::StaticOrder S; S.init(M, DM, G, bx);
                pg8::EpiResid E{XB, SS, nullptr};
                pg8::gemm_phase<pg8::EpiResid, pg8::StaticOrder>(ldsl, g, S, E);
            }
            SEAM2(P + 7, P + 10);
#if I8_IN
            if (PH_ON(7) && IN(P + 7)) { PHASE_WS();
                quant_rows(XB, XB8, SS, (float*)(ws + WS_RS), gw, NGW, lane);
            }
            if (!MK_PER_PHASE && IN(P + 7)) GRIDBAR();
#endif
        } else {
#define TOKE ((int*)(ws + WS_TOKE))
#define TOKG ((float*)(ws + WS_TOKG))
#define RSC ((float*)(ws + WS_RSC))
#define SLOT ((int*)(ws + WS_SLOT))
#define RS ((float*)(ws + WS_RS))
#define CNT ((int*)(ws + WS_CNT))
#define XG ((bf16*)(ws + WS_XG))
#define ACTG ((bf16*)(ws + WS_ACTG))
#define Y2 ((bf16*)(ws + 480 * MiB))
#define RPW (M / G)
            if (PH_ON(6) && IN(P + 6)) for (int rep_ = 0; rep_ < REP(6); ++rep_) { PHASE_WS();
                LAS float* RWt = (LAS float*)ldsl;
                LAS int* cnt = (LAS int*)(ldsl + 32768);
                for (int i = tid; i < DM * NEXP; i += NWAVES * 64) { const int k = i >> 3, e = i & 7; RWt[e * DM + k] = INPF(17)[i] * INPF(13)[DM + k]; }
                if (tid < 8) cnt[tid] = 0;
                __syncthreads();
                const int rpw = RPW / NWAVES;
                for (int i = 0; i < rpw; ++i) {
                    const int m = vcu * RPW + wave * rpw + i;
                    float lg[8] = {0.f, 0.f, 0.f, 0.f, 0.f, 0.f, 0.f, 0.f}; float ssq = 0.f, am = 0.f;
                    v4u xw[2];
#pragma unroll
                    for (int j = 0; j < 2; ++j) xw[j] = *(const GAS v4u*)(XB + (size_t)m * DM + lane * 8 + 512 * j);
#pragma unroll
                    for (int j = 0; j < 2; ++j) { float xv[8]; unpack8(xw[j], xv);
                        if (I8_MOE) {
#pragma unroll
                            for (int e = 0; e < 8; ++e) am = fmaxf(am, fabsf(xv[e])); }
                        ssq += ((xv[0] * xv[0] + xv[1] * xv[1]) + (xv[2] * xv[2] + xv[3] * xv[3])) + ((xv[4] * xv[4] + xv[5] * xv[5]) + (xv[6] * xv[6] + xv[7] * xv[7]));
#pragma unroll
                        for (int e = 0; e < 8; ++e) { const f32x4 wa = *(const LAS f32x4*)(RWt + e * DM + lane * 8 + 512 * j), wb = *(const LAS f32x4*)(RWt + e * DM + lane * 8 + 512 * j + 4);
                            lg[e] += ((xv[0] * wa[0] + xv[1] * wa[1]) + (xv[2] * wa[2] + xv[3] * wa[3])) + ((xv[4] * wb[0] + xv[5] * wb[1]) + (xv[6] * wb[2] + xv[7] * wb[3])); } }
                    ssq = wave_sum(ssq);
#pragma unroll
                    for (int e = 0; e < 8; ++e) lg[e] = wave_sum(lg[e]);
                    const float r = 1.0f / sqrtf(ssq * (1.0f / 1024.0f) + EPS);
                    float qsc = 1.0f;
                    if (I8_MOE) {
#pragma unroll
                        for (int o = 1; o < 64; o <<= 1) am = fmaxf(am, __shfl_xor(am, o));
                        const float inv = am > 0.f ? 127.0f / am : 0.f; qsc = am * (1.0f / 127.0f);
#pragma unroll
                        for (int j = 0; j < 2; ++j) { float xv[8]; unpack8(xw[j], xv); unsigned long long q = 0ull;
#pragma unroll
                            for (int e = 0; e < 8; ++e) q |= (unsigned long long)(unsigned)((int)__builtin_rintf(xv[e] * inv) & 255) << (8 * e);
                            *(GAS unsigned long long*)(XB8 + (size_t)m * DM + lane * 8 + 512 * j) = q; } }
                    int e0 = 0; float l0 = lg[0];
#pragma unroll
                    for (int e = 1; e < 8; ++e) if (lg[e] > l0) { l0 = lg[e]; e0 = e; }
                    int e1 = -1; float l1 = -__builtin_inff();
#pragma unroll
                    for (int e = 0; e < 8; ++e) if (e != e0 && lg[e] > l1) { l1 = lg[e]; e1 = e; }
                    const float g0 = 1.0f / (1.0f + expf((l1 - l0) * r)), g1 = 1.0f - g0;
                    if (lane == 0) { TOKE[m] = e0 | (e1 << 8); TOKG[2 * m] = g0; TOKG[2 * m + 1] = g1; RSC[m] = r * qsc;
                        __hip_atomic_fetch_add(cnt + e0, 1, __ATOMIC_RELAXED, __HIP_MEMORY_SCOPE_WORKGROUP); __hip_atomic_fetch_add(cnt + e1, 1, __ATOMIC_RELAXED, __HIP_MEMORY_SCOPE_WORKGROUP); }
                }
                __syncthreads();
                if (tid < 8) CNT[vcu * 8 + tid] = cnt[tid];
                __syncthreads();
            }
            SEAM(P + 6);
            if (PH_ON(7) && IN(P + 7)) { PHASE_WS();
                LAS int* tot = (LAS int*)ldsl; LAS int* pre = tot + 8; LAS int* slots_l = tot + 16;
                { int c = 0, cp = 0;
                  for (int j = 0; j < (G + 63) / 64; ++j) { const int idx = lane + 64 * j; if (idx < G) { const int v = CNT[idx * 8 + wave]; c += v; if (idx < vcu) cp += v; } }
#pragma unroll
                  for (int o = 1; o < 64; o <<= 1) { c += __shfl_xor(c, o); cp += __shfl_xor(cp, o); }
                  if (lane == 0) { tot[wave] = c; pre[wave] = cp; } }
                __syncthreads();
                int ce[9]; ce[0] = 0;
#pragma unroll
                for (int e = 0; e < 8; ++e) ce[e + 1] = ce[e] + (tot[e] + 255) / 256;
                if (vcu == 0 && tid == 0) {
#pragma unroll
                    for (int e = 0; e < 9; ++e) MISCI[MI_MOEC + e] = ce[e]; }
                if (wave == 0) {
                    int cur[8];
#pragma unroll
                    for (int e = 0; e < 8; ++e) cur[e] = 256 * ce[e] + pre[e];
                    const unsigned long long lt = (1ull << lane) - 1ull;
                    for (int ch = 0; ch < RPW / 64; ++ch) {
                        const int tl = ch * 64 + lane, tok = vcu * RPW + tl; const int ee = TOKE[tok]; const int e0 = ee & 255, e1 = ee >> 8; int s0 = 0, s1 = 0;
#pragma unroll
                        for (int e = 0; e < 8; ++e) { const unsigned long long m0 = __ballot(e0 == e), m1 = __ballot(e1 == e);
                            if (e0 == e) s0 = cur[e] + __popcll(m0 & lt);
                            if (e1 == e) s1 = cur[e] + __popcll(m0) + __popcll(m1 & lt);
                            cur[e] += __popcll(m0) + __popcll(m1); }
                        SLOT[2 * tok] = s0; SLOT[2 * tok + 1] = s1; slots_l[2 * tl] = s0; slots_l[2 * tl + 1] = s1;
                    }
                }
                __syncthreads();
                const int per = (2 * RPW) / NWAVES;
                for (int i = 0; i < per; ++i) { const int idx = wave * per + i, tl = idx >> 1, tok = vcu * RPW + tl; const int slot = slots_l[idx];
                    if (I8_MOE) { const v4u a = *(const GAS v4u*)(XB8 + (size_t)tok * DM + lane * 16); *(GAS v4u*)(XG8 + (size_t)slot * DM + lane * 16) = a; }
                    else { const v4u a = *(const GAS v4u*)(XB + (size_t)tok * DM + lane * 8), b2 = *(const GAS v4u*)(XB + (size_t)tok * DM + 512 + lane * 8);
                    *(GAS v4u*)(XG + (size_t)slot * DM + lane * 8) = a; *(GAS v4u*)(XG + (size_t)slot * DM + 512 + lane * 8) = b2; }
                    if (lane == 0) RS[slot] = RSC[tok]; }
                if (vcu < 8) {
                    int c0 = 0, c1 = 0, te = 0;
#pragma unroll
                    for (int e = 0; e < 8; ++e) if (e == vcu) { c0 = ce[e]; c1 = ce[e + 1]; te = tot[e]; }
                    for (int rrow = 256 * c0 + te + wave; rrow < 256 * c1; rrow += NWAVES) {
                        unsigned zz = 0u; asm volatile("" : "+v"(zz)); const v4u z4 = (v4u){zz, zz, zz, zz};
                        if (I8_MOE) *(GAS v4u*)(XG8 + (size_t)rrow * DM + lane * 16) = z4;
                        else { *(GAS v4u*)(XG + (size_t)rrow * DM + lane * 8) = z4; *(GAS v4u*)(XG + (size_t)rrow * DM + 512 + lane * 8) = z4; }
                        if (lane == 0) RS[rrow] = 0.f; }
                }
                __syncthreads();
            }
            SEAM(P + 7);
#define MOE_C RFL(MISCI[MI_MOEC + 1]), RFL(MISCI[MI_MOEC + 2]), RFL(MISCI[MI_MOEC + 3]), RFL(MISCI[MI_MOEC + 4]), RFL(MISCI[MI_MOEC + 5]), RFL(MISCI[MI_MOEC + 6]), RFL(MISCI[MI_MOEC + 7])
            if (PH_ON(8) && IN(P + 8)) { PHASE_WS();
                const int nrt = RFL(MISCI[MI_MOEC + 8]), nfull = nrt < 256 ? nrt : 256;
                pg8::MoeOrder S{MOE_C, 0, nfull, 11, G, bx};
#if I8_MOE
                pg8::Gemm g{(const bf16*)XG8, (const bf16*)(ws + WS_WMOE_GU), DM / 2, DM / 2};
                pg8::EpiSwiGLU E{ACTG, DFFE, RS, 1, (LAS float*)(ldsl + PART_OFF + 8192), 1.0f / WQ_I8};
                pg8::gemm_phase<pg8::EpiSwiGLU, pg8::MoeOrder, true, 2>(ldsl, g, S, E);
#else
                pg8::Gemm g{XG, (const bf16*)(ws + WS_WMOE_GU), DM, DM};
                pg8::EpiSwiGLU E{ACTG, DFFE, RS, 1, (LAS float*)(ldsl + PART_OFF + 8192), 1.0f};
                pg8::gemm_phase<pg8::EpiSwiGLU, pg8::MoeOrder>(ldsl, g, S, E);
#endif
            }
            SEAM(P + 8);
            if (PH_ON(9) && IN(P + 9)) {
                { PHASE_WS();
                  const int nrt = RFL(MISCI[MI_MOEC + 8]), nfull = nrt < 256 ? nrt : 256;
                  if (bx < (nrt - nfull) * 11) {
                      pg8::MoeOrder S{MOE_C, nfull, nrt, 11, G, bx};
#if I8_MOE
                      pg8::Gemm g{(const bf16*)XG8, (const bf16*)(ws + WS_WMOE_GU), DM / 2, DM / 2};
                      pg8::EpiSwiGLU E{ACTG, DFFE, RS, 1, (LAS float*)(ldsl + PART_OFF + 8192), 1.0f / WQ_I8};
                      pg8::gemm_phase<pg8::EpiSwiGLU, pg8::MoeOrder, true, 2>(ldsl, g, S, E);
#else
                      pg8::Gemm g{XG, (const bf16*)(ws + WS_WMOE_GU), DM, DM};
                      pg8::EpiSwiGLU E{ACTG, DFFE, RS, 1, (LAS float*)(ldsl + PART_OFF + 8192), 1.0f};
                      pg8::gemm_phase<pg8::EpiSwiGLU, pg8::MoeOrder>(ldsl, g, S, E);
#endif
                      int mine = 0; for (int L = bx; L < (nrt - nfull) * 11; L += G) ++mine;
                      asm volatile("s_waitcnt vmcnt(0)" ::: "memory");
                      __syncthreads();
                      if (tid == 0) { __builtin_amdgcn_fence(__ATOMIC_RELEASE, "agent"); asm volatile("s_waitcnt vmcnt(0)" ::: "memory");
                          __hip_atomic_fetch_add((unsigned*)(ws + WS_CTL) + CW_TAIL, (unsigned)mine, __ATOMIC_RELAXED, __HIP_MEMORY_SCOPE_AGENT); }
                      __syncthreads();
                  } }
                { PHASE_WS();
                  const int nrt = RFL(MISCI[MI_MOEC + 8]), nfull = nrt < 256 ? nrt : 256, nb = (nrt - nfull) * 11;
                  const int rs = nfull - (nb + 3) / 4, rank = bx >= nb ? bx - nb : G - nb + bx;
                  pg8::MoeOrder S{MOE_C, 0, rs, 4, G, rank};
                  pg8::Gemm g{ACTG, (const bf16*)(ws + WS_WMOE_D), DFFE, DFFE};
                  pg8::EpiScaleBf16 E{XG, DM, nullptr};
                  pg8::gemm_phase<pg8::EpiScaleBf16, pg8::MoeOrder>(ldsl, g, S, E); }
                { PHASE_WS();
                  const int nrt = RFL(MISCI[MI_MOEC + 8]), nfull = nrt < 256 ? nrt : 256, nb = (nrt - nfull) * 11;
                  const int rs = nfull - (nb + 3) / 4, rank = bx >= nb ? bx - nb : G - nb + bx;
                  const int F = 4 * rs, nh = 8 * (nrt - rs);
                  int q = rank - (F % G); if (q < 0) q += G;
                  const int on = q < nh;
                  const int uq = q >> 1, half = q & 1, rt = rs + (uq >> 2), ct = uq & 3;
                  if (on && rt >= nfull) {
                      __syncthreads();
                      if (wave == 0) { const unsigned need = (unsigned)nb; gu32* tc = (gu32*)(ws + WS_CTL) + CW_TAIL; gu32* tmo = (gu32*)(ws + WS_CTL) + CW_BAR + XB_TMO; unsigned sp = 0;
                          while ((unsigned)__builtin_amdgcn_readfirstlane(__hip_atomic_load(tc, __ATOMIC_RELAXED, __HIP_MEMORY_SCOPE_AGENT)) < need) {
                              __builtin_amdgcn_s_sleep(2);
                              if ((++sp & 255u) == 0u) { if (__builtin_amdgcn_readfirstlane(__hip_atomic_load(tmo, __ATOMIC_RELAXED, __HIP_MEMORY_SCOPE_AGENT))) break;
                                  if (sp > XB_SPIN_CAP) { if (lane == 0) __hip_atomic_fetch_add(tmo, 1u, __ATOMIC_RELAXED, __HIP_MEMORY_SCOPE_AGENT); break; } } }
                          __builtin_amdgcn_fence(__ATOMIC_ACQUIRE, "agent");
                          asm volatile("s_waitcnt vmcnt(0)" ::: "memory"); }
                      __syncthreads();
                  }
                  if (on) {
                      const int c1 = RFL(MISCI[MI_MOEC + 1]), c2 = RFL(MISCI[MI_MOEC + 2]), c3 = RFL(MISCI[MI_MOEC + 3]), c4 = RFL(MISCI[MI_MOEC + 4]), c5 = RFL(MISCI[MI_MOEC + 5]), c6 = RFL(MISCI[MI_MOEC + 6]), c7 = RFL(MISCI[MI_MOEC + 7]);
                      const int e = (rt >= c1) + (rt >= c2) + (rt >= c3) + (rt >= c4) + (rt >= c5) + (rt >= c6) + (rt >= c7);
                      const int koff = half ? 768 : 0;
                      pg8::OneUnit S{{rt, e * 4 + ct, ct}, 1};
                      pg8::Gemm g{ACTG + koff, (const bf16*)(ws + WS_WMOE_D) + koff, DFFE, half ? DFFE - 768 : 768, DFFE};
                      pg8::EpiScaleBf16 E{half ? Y2 - (size_t)rs * 256 * DM : XG, DM, nullptr};
                      pg8::gemm_phase<pg8::EpiScaleBf16, pg8::OneUnit>(ldsl, g, S, E);
                  } }
            }
            SEAM(P + 9);
            if (PH_ON(10) && IN(P + 10)) { PHASE_WS();
                const int nrt_ = RFL(MISCI[MI_MOEC + 8]), nfull_ = nrt_ < 256 ? nrt_ : 256, ssp = (nfull_ - ((nrt_ - nfull_) * 11 + 3) / 4) * 256;
                for (int m = gw; m < M; m += NGW) {
                    const int s0 = SLOT[2 * m], s1 = SLOT[2 * m + 1]; const float g0 = TOKG[2 * m], g1 = TOKG[2 * m + 1];
#pragma unroll
                    for (int j = 0; j < 2; ++j) { const int col = lane * 8 + 512 * j;
                        float y0[8], y1[8]; unpack8(*(const GAS v4u*)(XG + (size_t)s0 * DM + col), y0); unpack8(*(const GAS v4u*)(XG + (size_t)s1 * DM + col), y1);
                        if (s0 >= ssp) { float t[8]; unpack8(*(const GAS v4u*)(Y2 + (size_t)(s0 - ssp) * DM + col), t);
#pragma unroll
                            for (int e = 0; e < 8; ++e) y0[e] += t[e]; }
                        if (s1 >= ssp) { float t[8]; unpack8(*(const GAS v4u*)(Y2 + (size_t)(s1 - ssp) * DM + col), t);
#pragma unroll
                            for (int e = 0; e < 8; ++e) y1[e] += t[e]; }
                        float xr[8]; unpack8(*(const GAS v4u*)(XB + (size_t)m * DM + col), xr);
                        GAS f32x4* op = (GAS f32x4*)(outp + (size_t)m * DM + col); f32x4 a, b2;
#pragma unroll
                        for (int e = 0; e < 4; ++e) { a[e] = xr[e] + g0 * y0[e] + g1 * y1[e]; b2[e] = xr[4 + e] + g0 * y0[4 + e] + g1 * y1[4 + e]; }
                        op[0] = a; op[1] = b2; }
                }
            }
        }
    }
#undef IN
#undef SEAM
#undef SEAM2
}

extern "C" void kernel_launch(void* const* d_in, const int* in_sizes, int n_in, void* d_out, int out_size, void* d_ws, size_t ws_size, hipStream_t stream) {
    static int grid = 0;
    if (grid == 0) {
        if (n_in != 21 || in_sizes[0] != M * DM || out_size != M * DM || ws_size < WS_END) {
            fprintf(stderr, "kernel_launch: unexpected shapes (n_in %d, in0 %d, out %d, ws %zu); nothing launched\n", n_in, n_in > 0 ? in_sizes[0] : -1, out_size, ws_size); grid = -1; return; }
        int dev = 0, cus = 0, per_cu = 0;
        if (hipGetDevice(&dev) != hipSuccess || hipDeviceGetAttribute(&cus, hipDeviceAttributeMultiprocessorCount, dev) != hipSuccess) { grid = -1; return; }
        if (hipFuncSetAttribute((const void*)fwd_kernel, hipFuncAttributeMaxDynamicSharedMemorySize, LDS_BYTES) != hipSuccess) { fprintf(stderr, "kernel_launch: hipFuncSetAttribute failed\n"); grid = -1; return; }
        if (hipOccupancyMaxActiveBlocksPerMultiprocessor(&per_cu, (const void*)fwd_kernel, NWAVES * 64, LDS_BYTES) != hipSuccess || per_cu < 1)
            fprintf(stderr, "kernel_launch: note: occupancy query reports %d workgroups per CU\n", per_cu);
        (void)hipGetLastError();
        grid = cus;
        if (grid > 256) grid = 256;
        if (grid != 256) fprintf(stderr, "kernel_launch: %d CUs; this kernel's MoE routing phases are dealt for 256 workgroups\n", grid);
    }
    if (grid < 0) return;
    (void)hipMemsetAsync((char*)d_ws + WS_CTL, 0, CTL_ZERO_BYTES, stream);
    Args a{};
    for (int i = 0; i < 21; ++i) a.in[i] = (const float*)d_in[i];
    a.out = (float*)d_out; a.ws = (unsigned char*)d_ws;
#if MK_PER_PHASE
    for (int ph = 0; ph <= 21; ++ph) { if (ph == 9 || ph == 10 || ph == 2 || ph == 12 || ph == 4 || ph == 14) continue; a.ph_lo = ph; a.ph_hi = ph + 1;
        hipLaunchKernelGGL(fwd_kernel, dim3(grid), dim3(NWAVES * 64), LDS_BYTES, stream, a); }
#else
    a.ph_lo = 0; a.ph_hi = 22;
    hipLaunchKernelGGL(fwd_kernel, dim3(grid), dim3(NWAVES * 64), LDS_BYTES, stream, a);
#endif
}
```

```cpp
#include <hip/hip_runtime.h>
#include <cstdio>
#include <cstdint>

#ifndef MK_PER_PHASE
#define MK_PER_PHASE 0
#endif
#ifndef PH_MASK
#define PH_MASK 0xFFFF
#endif
#ifndef ATT_SEL
#define ATT_SEL 7
#endif
#define PH_ON(j) (((PH_MASK) >> (j)) & 1)
#ifndef DUP_MASK
#define DUP_MASK 0
#endif
#ifndef DUP_BAR
#define DUP_BAR 0
#endif
#ifndef I8_AO
#define I8_AO 1
#endif
#ifndef I8_UQ
#define I8_UQ 1
#endif
#ifndef QPRED
#define QPRED 1
#endif
#ifndef I8_G2
#define I8_G2 1
#endif
#ifndef I8_DN
#define I8_DN 1
#endif
#ifndef I8_IN
#define I8_IN 1
#endif
#ifndef I8_MOE
#define I8_MOE 1
#endif
#ifndef FP8_GU
#define FP8_GU 2
#endif
#ifndef PROBE_NULL_GU
#define PROBE_NULL_GU 0
#endif
#define REP(j) ((((DUP_MASK) >> (j)) & 1) ? 2 : 1)

constexpr int BATCH = 8, SEQ = 4096, DM = 1024, DEPTH = 2;
constexpr int M = BATCH * SEQ;
constexpr int INC = 1984, INCP = 2048;
constexpr int DFF = 2816, DFFE = 1408, NEXP = 8;
constexpr int MQR = 256, MKR = 128;
constexpr int SLOTS = 2 * M + NEXP * 256;
constexpr float EPS = 1e-6f;
constexpr float LOG2E = 1.4426950408889634f;

constexpr size_t MiB = 1u << 20;
constexpr size_t WS_CTL = 0, CTL_ZERO_BYTES = 64 * 1024;
constexpr size_t WS_SS = 1 * MiB;
constexpr size_t WS_ROPD = 3 * MiB;
constexpr size_t WS_ROPM = WS_ROPD + 256 * 1024;
constexpr size_t WS_MISC = WS_ROPM + 1 * MiB;
constexpr size_t WS_RW = WS_MISC + 64 * 1024;
constexpr size_t WS_CNT = WS_RW + 32 * 1024;
constexpr size_t WS_TOKE = 5 * MiB;
constexpr size_t WS_TOKG = WS_TOKE + (size_t)M * 4;
constexpr size_t WS_RSC = WS_TOKG + (size_t)M * 8;
constexpr size_t WS_SLOT = WS_RSC + (size_t)M * 4;
constexpr size_t WS_RS = WS_SLOT + (size_t)M * 8;
constexpr size_t WS_KPESS = WS_RS + (size_t)SLOTS * 4;
constexpr size_t WS_WMOE_GU = 8 * MiB;
constexpr size_t WS_WMOE_D = 52 * MiB;
constexpr size_t WS_W1 = 74 * MiB;
constexpr size_t WS_XB = 81 * MiB;
constexpr size_t WS_AO = 145 * MiB;
constexpr size_t WS_QM = 209 * MiB;
constexpr size_t WS_KVU = 257 * MiB;
constexpr size_t WS_KM = 321 * MiB;
constexpr size_t WS_W0 = 369 * MiB;
constexpr size_t WS_PROJ1 = 369 * MiB;
constexpr size_t WS_ACT0 = 145 * MiB;
constexpr size_t WS_XG = 145 * MiB;
constexpr size_t WS_ACTG = 277 * MiB;
constexpr size_t WS_END = 497 * MiB;
constexpr size_t WOFF_IN = 0, WOFF_UQ = 4 * MiB, WOFF_UKV = WOFF_UQ + 512 * 1024, WOFF_O = WOFF_UKV + 256 * 1024, WOFF_GU = WOFF_O + 2 * MiB, WOFF_D = WOFF_GU + 11 * MiB;
static_assert(WS_KPESS + (size_t)M * 4 <= WS_WMOE_GU && WOFF_D + (size_t)DM * DFF * 2 <= 24 * MiB && WS_ACTG + (size_t)SLOTS * DFFE * 2 <= WS_END && WS_XG + (size_t)SLOTS * DM * 2 <= WS_ACTG, "d_ws map");
static_assert(WS_ACT0 + (size_t)M * DFF * 2 <= WS_W0, "dense act clear of layer-0 weights");

constexpr int CW_TMO = 0, CW_BAR = 4096, CW_TAIL = 8192;
constexpr int MI_LAM = 0, MI_BIASD = 2, MI_BIASM = 4, MI_MOEC = 16;
constexpr int MI_GT = 1024, GT_L = 1024, GT_GQ = 0, GT_GK = 64, GT_QLN = 128, GT_KVLN = 384, GT_QK = 512, GT_SUB = 896;

constexpr int NWAVES = 8;
constexpr int RING_BYTES = 131072, LDSCTL_OFF = RING_BYTES, MISC_OFF = LDSCTL_OFF + 320;
constexpr int LDS_BYTES = 147456;
constexpr int PART_OFF = RING_BYTES + 1024;

constexpr float WQ_I8 = 127.0f * 32.0f / 4.0f;
__device__ __forceinline__ unsigned pk4_u8b(float a, float b, float c, float d) {
    unsigned w = __builtin_amdgcn_cvt_pk_u8_f32(a, 0, 0u); w = __builtin_amdgcn_cvt_pk_u8_f32(b, 1, w); w = __builtin_amdgcn_cvt_pk_u8_f32(c, 2, w); w = __builtin_amdgcn_cvt_pk_u8_f32(d, 3, w); return w ^ 0x80808080u;
}
__device__ __forceinline__ unsigned pk4_i8(float a, float b, float c, float d) {
    unsigned w = __builtin_amdgcn_cvt_pk_u8_f32(a + 128.0f, 0, 0u); w = __builtin_amdgcn_cvt_pk_u8_f32(b + 128.0f, 1, w);
    w = __builtin_amdgcn_cvt_pk_u8_f32(c + 128.0f, 2, w); w = __builtin_amdgcn_cvt_pk_u8_f32(d + 128.0f, 3, w); return w ^ 0x80808080u;
}
constexpr float WQ_DN = 127.0f * 53.0659f / 4.0f;
constexpr float WQ_DM = 127.0f * 37.5233f / 4.0f;
constexpr int DFFP = 1536;
constexpr float WQ_UQ = 127.0f * 16.0f / 4.0f;
constexpr float CQ_STEP = 4.0f / 127.0f;
constexpr float AO_MLA_CLIP = 2.0f;
constexpr float ACT_CLIP = 7.0f;
namespace pg8 {
#define PG8_LAS __attribute__((address_space(3)))
typedef unsigned short bf16_t;
typedef short bf16x8 __attribute__((ext_vector_type(8)));
typedef float f32x4 __attribute__((ext_vector_type(4)));
typedef unsigned u32x4 __attribute__((ext_vector_type(4)));
typedef int i32x4 __attribute__((ext_vector_type(4)));
typedef float f32x2 __attribute__((ext_vector_type(2)));
typedef int i32x8 __attribute__((ext_vector_type(8)));
constexpr int BM = 256, BK = 64, HALF = 128, HTB = HALF * BK * 2, STAGE_BYTES = 8 * HTB, NXCD = 8, WGM = 8;

__host__ __device__ __forceinline__ int lds_byte(int r, int c) { const int st = (r >> 4) * 2 + (c >> 5), rr = r & 15, cc = c & 31, ob = rr * 64 + cc * 2; return st * 1024 + (ob ^ (((ob >> 9) & 1) << 5)); }
__host__ __device__ __forceinline__ void stage_rc(int b, int& R, int& C) { const int st = b / 1024, sb = b % 1024, swz = sb ^ (((sb >> 9) & 1) << 5); R = (st >> 1) * 16 + swz / 64; C = (st & 1) * 32 + (swz % 64) / 2; }
__host__ __device__ __forceinline__ int perm32(int rho) { const int n = rho >> 4, i = rho & 15; return 8 * (i >> 2) + 4 * n + (i & 3); }

struct Unit { int pm, pn, cn; };
struct Gemm { const bf16_t* A; const bf16_t* Bt; int lda, K, ldb; };

struct StaticOrder {
    int nM, nN, nwg, G, c;
    __device__ void init(int M_, int N_, int G_, int c_) { nM = M_ / BM; nN = N_ / BM; nwg = nM * nN; G = G_; c = c_; }
    __device__ bool next(int i, Unit& u) const {
        const long L = (long)i * G + c; if (L >= nwg) return false;
        int wgid = (int)L; { const int q = nwg / NXCD, r = nwg % NXCD, xcd = wgid % NXCD, off = wgid / NXCD; wgid = (xcd < r ? xcd * (q + 1) : r * (q + 1) + (xcd - r) * q) + off; }
        const int nig = WGM * nN, gid = wgid / nig, fm = gid * WGM, win = wgid - gid * nig;
        u.pm = fm + (win % WGM); u.pn = win / WGM; u.cn = u.pn; return true;
    }
};
struct MoeOrder {
    int c1, c2, c3, c4, c5, c6, c7, rlo, rhi, ncol, G, c;
    __device__ bool next(int i, Unit& u) const {
        const int L = i * G + c; if (L >= (rhi - rlo) * ncol) return false;
        const int q = ncol == 4 ? (L >> 2) : (ncol == 11 ? L / 11 : L / ncol), rt = rlo + q, j = L - q * ncol;
        const int e = (rt >= c1) + (rt >= c2) + (rt >= c3) + (rt >= c4) + (rt >= c5) + (rt >= c6) + (rt >= c7);
        u.pm = rt; u.pn = e * ncol + j; u.cn = j; return true;
    }
};

struct OneUnit { Unit u; int on; __device__ bool next(int i, Unit& o) const { if (i != 0 || !on) return false; o = u; return true; } };

__device__ __forceinline__ unsigned cvt_pk_bf16(float lo, float hi) { unsigned r; asm volatile("v_cvt_pk_bf16_f32 %0, %1, %2" : "=v"(r) : "v"(lo), "v"(hi)); return r; }
__device__ __forceinline__ u32x4 pack8(f32x4 a, f32x4 b) { u32x4 w; w.x = cvt_pk_bf16(a[0], a[1]); w.y = cvt_pk_bf16(a[2], a[3]); w.z = cvt_pk_bf16(b[0], b[1]); w.w = cvt_pk_bf16(b[2], b[3]); return w; }
__device__ __forceinline__ float row_scale16(const float* ss, int row, int fq) {
    const f32x4 p = *(const f32x4*)(ss + (size_t)row * 16 + 4 * fq); float s = (p[0] + p[1]) + (p[2] + p[3]);
    s += __shfl_xor(s, 16); s += __shfl_xor(s, 32); return __builtin_amdgcn_rsqf(s * (1.0f / 1024.0f) + EPS);
}
struct RsPref { f32x4 a, b, c, d; };
__device__ __forceinline__ void rs_issue(RsPref& r, float& re, const float* ss, int direct, int pm, int tid, const float* qs) {
    if (tid < 256) { const int row = pm * BM + tid; if (qs) re = qs[row];
        if (direct) { r.a[0] = ss[row]; }
        else { const f32x4* p = (const f32x4*)(ss + (size_t)row * 16); r.a = p[0]; r.b = p[1]; r.c = p[2]; r.d = p[3]; } }
}
__device__ __forceinline__ void rs_commit(const RsPref& r, float re, int direct, PG8_LAS float* rs, int parity, int tid, const float* qs) {
    if (tid < 256) { float v;
        if (direct) v = r.a[0];
        else { const f32x4 t = (r.a + r.b) + (r.c + r.d); v = __builtin_amdgcn_rsqf(((t[0] + t[1]) + (t[2] + t[3])) * (1.0f / 1024.0f) + EPS); }
        rs[parity * 256 + tid] = qs ? v * re : v; }
}
struct EpiScaleBf16 {
    static constexpr bool PERM = true, PREF = false;
    bf16_t* O; int ldc; const float* ss; float wsc;
    __device__ __forceinline__ void operator()(const f32x4 (&acc)[2][2][4][2], const Unit& u, int wr, int wc, int fr, int fq, int par) const {
        const int row0 = u.pm * BM + wr * 64 + fr, col0 = u.cn * BM + wc * 32 + 8 * fq;
#pragma unroll
        for (int ai = 0; ai < 2; ++ai)
#pragma unroll
            for (int m = 0; m < 4; ++m) { const int row = row0 + ai * HALF + m * 16; float sc = wsc; if (ss) sc = row_scale16(ss, row, fq) * wsc;
                bf16_t* rowp = O + (size_t)row * ldc + col0;
#pragma unroll
                for (int bj = 0; bj < 2; ++bj) *(u32x4*)(rowp + bj * HALF) = pack8(acc[ai][bj][m][0] * sc, acc[ai][bj][m][1] * sc); }
    }
};
struct EpiInProj {
    static constexpr bool PERM = true, PREF = true; static constexpr int direct = I8_IN ? 1 : 0; static constexpr const float* qs = nullptr;
    bf16_t* PROJ; unsigned char* wsb; const float* gt; PG8_LAS float* part; const float* ss; PG8_LAS float* rsl; bf16_t* cqn;
    __device__ __forceinline__ void operator()(f32x4 (&acc)[2][2][4][2], const Unit& u, int wr, int wc, int fr, int fq, int par) const {
        bf16_t* const CQN = cqn; bf16_t* const CKVN = cqn + (size_t)M * MQR;
        const float* const ropd = (const float*)(wsb + WS_ROPD); const float* const ropm = (const float*)(wsb + WS_ROPM);
        bf16_t* const KPR = (bf16_t*)(wsb + WS_KVU + 32 * MiB); float* const kpess = (float*)(wsb + WS_KPESS);
        const float* const gq = gt + GT_GQ; const float* const gk = gt + GT_GK; const float* const gqln = gt + GT_QLN; const float* const gkvln = gt + GT_KVLN; const float* const gk192 = gt + GT_QK + 192;
        int rl0_ = wr * 64 + fr; asm volatile("" : "+v"(rl0_));
        const int rl0 = rl0_, row0 = u.pm * BM + rl0, cn = u.cn;
        PG8_LAS float* const pw = part + rl0 * 8 + wc; PG8_LAS float* const px = part + rl0 * 8 + (wc ^ 1); PG8_LAS float* const p0 = part + rl0 * 8;
#pragma unroll
        for (int ai = 0; ai < 2; ++ai)
#pragma unroll
            for (int m = 0; m < 4; ++m) { const int rl = rl0 + ai * HALF + m * 16; const float rx = rsl[par * 256 + rl] * (I8_IN ? 1.0f / WQ_I8 : 1.0f);
#pragma unroll
                for (int bj = 0; bj < 2; ++bj) { f32x4 v0 = acc[ai][bj][m][0] * rx, v1 = acc[ai][bj][m][1] * rx; acc[ai][bj][m][0] = v0; acc[ai][bj][m][1] = v1;
                    float q = (v0[0] * v0[0] + v0[1] * v0[1]) + (v0[2] * v0[2] + v0[3] * v0[3]) + (v1[0] * v1[0] + v1[1] * v1[1]) + (v1[2] * v1[2] + v1[3] * v1[3]);
                    q += __shfl_xor(q, 16); q += __shfl_xor(q, 32);
                      pw[(ai * HALF + m * 16) * 8 + bj * 4] = q; } }
        asm volatile("s_waitcnt lgkmcnt(0)\n\ts_barrier" ::: "memory");
        const int cw = wc * 32 + 8 * fq;
        if (cn < 4) {
            const bool isq = cn < 2; const float* gp = isq ? gq : gk; const float gsc = isq ? 0.125f * LOG2E : 1.0f;
            float gv[8];
#pragma unroll
            for (int e = 0; e < 8; ++e) { const int pos = (cw & 63) + e, dim = pos < 16 ? (pos >> 1) + 8 * (pos & 1) : pos; gv[e] = gp[dim] * gsc; }
            const bool ropew = (wc & 1) == 0;
#pragma unroll
            for (int ai = 0; ai < 2; ++ai)
#pragma unroll
                for (int m = 0; m < 4; ++m) { const int rl = rl0 + ai * HALF + m * 16, row = u.pm * BM + rl;
                    float cs[8], sn[8];
                    if (ropew) { const float* rp = ropd + (size_t)(row & (SEQ - 1)) * 16; const f32x4 c0 = *(const f32x4*)rp, c1 = *(const f32x4*)(rp + 4), s0 = *(const f32x4*)(rp + 8), s1 = *(const f32x4*)(rp + 12);
#pragma unroll
                        for (int e = 0; e < 4; ++e) { cs[e] = c0[e]; cs[4 + e] = c1[e]; sn[e] = s0[e]; sn[4 + e] = s1[e]; } }
#pragma unroll
                    for (int bj = 0; bj < 2; ++bj) { const float sq = pw[(ai * HALF + m * 16) * 8 + bj * 4] + px[(ai * HALF + m * 16) * 8 + bj * 4]; const float rinv = __builtin_amdgcn_rsqf(sq * (1.0f / 64.0f) + EPS);
                        float v[8];
#pragma unroll
                        for (int e = 0; e < 4; ++e) { v[e] = acc[ai][bj][m][0][e] * rinv * gv[e]; v[4 + e] = acc[ai][bj][m][1][e] * rinv * gv[4 + e]; }
                        if (ropew) {
#pragma unroll
                            for (int j = 0; j < 4; ++j) { const float c = fq == 0 ? cs[j] : cs[4 + j], sI = fq == 0 ? sn[j] : sn[4 + j];
                                const float x1 = v[2 * j], x2 = v[2 * j + 1], y1 = x1 * c - x2 * sI, y2 = x2 * c + x1 * sI;
                                v[2 * j] = fq < 2 ? y1 : x1; v[2 * j + 1] = fq < 2 ? y2 : x2; } }
                        *(u32x4*)(PROJ + (size_t)row * INCP + cn * BM + bj * HALF + cw) = pack8((f32x4){v[0], v[1], v[2], v[3]}, (f32x4){v[4], v[5], v[6], v[7]}); }
                    asm volatile("" ::: "memory"); }
        } else if (cn < 6) {
#pragma unroll
            for (int ai = 0; ai < 2; ++ai)
#pragma unroll
                for (int m = 0; m < 4; ++m) { const int row = row0 + ai * HALF + m * 16;
#pragma unroll
                    for (int bj = 0; bj < 2; ++bj) *(u32x4*)(PROJ + (size_t)row * INCP + cn * BM + bj * HALF + cw) = pack8(acc[ai][bj][m][0], acc[ai][bj][m][1]); }
        } else if (cn == 6) {
            float gv[2][8];
#pragma unroll
            for (int bj = 0; bj < 2; ++bj)
#pragma unroll
                for (int e = 0; e < 8; ++e) gv[bj][e] = gqln[bj * HALF + cw + e];
#pragma unroll
            for (int ai = 0; ai < 2; ++ai)
#pragma unroll
                for (int m = 0; m < 4; ++m) { const int rl = rl0 + ai * HALF + m * 16, row = u.pm * BM + rl;
                    const f32x4 pa = *(const PG8_LAS f32x4*)(p0 + (ai * HALF + m * 16) * 8), pb = *(const PG8_LAS f32x4*)(p0 + (ai * HALF + m * 16) * 8 + 4);
                    const float rinv = __builtin_amdgcn_rsqf(((pa[0] + pa[1]) + (pa[2] + pa[3]) + (pb[0] + pb[1]) + (pb[2] + pb[3])) * (1.0f / 256.0f) + EPS);
#pragma unroll
                    for (int bj = 0; bj < 2; ++bj) { f32x4 v0 = acc[ai][bj][m][0] * rinv, v1 = acc[ai][bj][m][1] * rinv;
#pragma unroll
                        for (int e = 0; e < 4; ++e) { v0[e] *= gv[bj][e]; v1[e] *= gv[bj][4 + e]; }
                        if (I8_UQ) *(unsigned long long*)((unsigned char*)CQN + (size_t)row * 256 + bj * HALF + cw) = (unsigned long long)pk4_i8(v0[0] * (1.0f / CQ_STEP), v0[1] * (1.0f / CQ_STEP), v0[2] * (1.0f / CQ_STEP), v0[3] * (1.0f / CQ_STEP)) | ((unsigned long long)pk4_i8(v1[0] * (1.0f / CQ_STEP), v1[1] * (1.0f / CQ_STEP), v1[2] * (1.0f / CQ_STEP), v1[3] * (1.0f / CQ_STEP)) << 32);
                        else *(u32x4*)(CQN + (size_t)row * 256 + bj * HALF + cw) = pack8(v0, v1); } }
        } else {
            float gv[8], gkp[8];
#pragma unroll
            for (int e = 0; e < 8; ++e) { gv[e] = gkvln[cw + e]; const int p = (cw & 63) + e; gkp[e] = gk192[128 + (p >> 1) + 32 * (p & 1)]; }
#pragma unroll
            for (int ai = 0; ai < 2; ++ai)
#pragma unroll
                for (int m = 0; m < 4; ++m) { const int rl = rl0 + ai * HALF + m * 16, row = u.pm * BM + rl;
                    const f32x4 pa = *(const PG8_LAS f32x4*)(p0 + (ai * HALF + m * 16) * 8);
                    const float rinv = __builtin_amdgcn_rsqf(((pa[0] + pa[1]) + (pa[2] + pa[3])) * (1.0f / 128.0f) + EPS);
                    f32x4 v0 = acc[ai][0][m][0] * rinv, v1 = acc[ai][0][m][1] * rinv;
#pragma unroll
                    for (int e = 0; e < 4; ++e) { v0[e] *= gv[e]; v1[e] *= gv[4 + e]; }
                    *(u32x4*)(CKVN + (size_t)row * 128 + cw) = pack8(v0, v1);
                    if (wc < 2) {
                        const f32x4 pb = *(const PG8_LAS f32x4*)(p0 + (ai * HALF + m * 16) * 8 + 4);
                        if (wc == 0 && fq == 0) kpess[row] = pb[0] + pb[1];
                        const float* rp = ropm + (size_t)(row & (SEQ - 1)) * 64 + (cw >> 1); const f32x4 c4 = *(const f32x4*)rp, s4 = *(const f32x4*)(rp + 32);
                        float x[8];
#pragma unroll
                        for (int e = 0; e < 4; ++e) { x[e] = acc[ai][1][m][0][e] * gkp[e]; x[4 + e] = acc[ai][1][m][1][e] * gkp[4 + e]; }
                        float y[8];
#pragma unroll
                        for (int j = 0; j < 4; ++j) { y[2 * j] = x[2 * j] * c4[j] - x[2 * j + 1] * s4[j]; y[2 * j + 1] = x[2 * j + 1] * c4[j] + x[2 * j] * s4[j]; }
                        *(u32x4*)(KPR + (size_t)row * 64 + cw) = pack8((f32x4){y[0], y[1], y[2], y[3]}, (f32x4){y[4], y[5], y[6], y[7]}); }
                    asm volatile("" ::: "memory"); }
        }
    }
};
struct EpiMlaQ {
    static constexpr bool PERM = true, PREF = false;
    bf16_t* QM; const float* ropm; const float* g; PG8_LAS float* part; float asc;
    __device__ __forceinline__ void operator()(f32x4 (&acc)[2][2][4][2], const Unit& u, int wr, int wc, int fr, int fq, int par) const {
        int rl0_ = wr * 64 + fr; asm volatile("" : "+v"(rl0_));
        const int rl0 = rl0_, h = u.cn, cw = wc * 32 + 8 * fq;
        PG8_LAS float* const pw = part + rl0 * 8 + wc; PG8_LAS float* const p0 = part + rl0 * 8;
#pragma unroll
        for (int ai = 0; ai < 2; ++ai)
#pragma unroll
            for (int m = 0; m < 4; ++m)
#pragma unroll
                for (int bj = 0; bj < 2; ++bj) {
#pragma unroll
                    for (int e = 0; e < 4; ++e) { acc[ai][bj][m][0][e] *= asc; acc[ai][bj][m][1][e] *= asc; }
                    const f32x4 v0 = acc[ai][bj][m][0], v1 = acc[ai][bj][m][1];
                    float q = (v0[0] * v0[0] + v0[1] * v0[1]) + (v0[2] * v0[2] + v0[3] * v0[3]) + (v1[0] * v1[0] + v1[1] * v1[1]) + (v1[2] * v1[2] + v1[3] * v1[3]);
                    q += __shfl_xor(q, 16); q += __shfl_xor(q, 32);
                      pw[(ai * HALF + m * 16) * 8 + bj * 4] = q; }
        asm volatile("s_waitcnt lgkmcnt(0)\n\ts_barrier" ::: "memory");
        constexpr float C2 = 0.07216878364870322f * LOG2E;
        float g0[8], g1[8];
#pragma unroll
        for (int e = 0; e < 8; ++e) { g0[e] = g[cw + e] * C2; const int p = (cw & 63) + e; g1[e] = g[128 + (p >> 1) + 32 * (p & 1)] * C2; }
#pragma unroll
        for (int ai = 0; ai < 2; ++ai)
#pragma unroll
            for (int m = 0; m < 4; ++m) { const int row = u.pm * BM + rl0 + ai * HALF + m * 16;
                const f32x4 pa = *(const PG8_LAS f32x4*)(p0 + (ai * HALF + m * 16) * 8), pb = *(const PG8_LAS f32x4*)(p0 + (ai * HALF + m * 16) * 8 + 4);
                const float rinv = __builtin_amdgcn_rsqf(((pa[0] + pa[1]) + (pa[2] + pa[3]) + (pb[0] + pb[1]) + (pb[2] + pb[3])) * (1.0f / 192.0f) + EPS);
                { f32x4 v0 = acc[ai][0][m][0] * rinv, v1 = acc[ai][0][m][1] * rinv;
#pragma unroll
                  for (int e = 0; e < 4; ++e) { v0[e] *= g0[e]; v1[e] *= g0[4 + e]; }
                  *(u32x4*)(QM + (size_t)row * 768 + h * 192 + cw) = pack8(v0, v1); }
                if (wc < 2) { const float* rp = ropm + (size_t)(row & (SEQ - 1)) * 64 + (cw >> 1); const f32x4 c4 = *(const f32x4*)rp, s4 = *(const f32x4*)(rp + 32);
                    float x[8], y[8];
#pragma unroll
                    for (int e = 0; e < 4; ++e) { x[e] = acc[ai][1][m][0][e] * rinv * g1[e]; x[4 + e] = acc[ai][1][m][1][e] * rinv * g1[4 + e]; }
#pragma unroll
                    for (int j = 0; j < 4; ++j) { y[2 * j] = x[2 * j] * c4[j] - x[2 * j + 1] * s4[j]; y[2 * j + 1] = x[2 * j + 1] * c4[j] + x[2 * j] * s4[j]; }
                    *(u32x4*)(QM + (size_t)row * 768 + h * 192 + 128 + cw) = pack8((f32x4){y[0], y[1], y[2], y[3]}, (f32x4){y[4], y[5], y[6], y[7]}); }
                asm volatile("" ::: "memory"); }
    }
};
struct EpiMlaKV {
    static constexpr bool PERM = true, PREF = false;
    bf16_t* KM; const bf16_t* KPR; const float* kpess; const float* g; PG8_LAS float* part;
    __device__ __forceinline__ void operator()(f32x4 (&acc)[2][2][4][2], const Unit& u, int wr, int wc, int fr, int fq, int par) const {
        int rl0_ = wr * 64 + fr; asm volatile("" : "+v"(rl0_));
        const int rl0 = rl0_, h0 = 2 * u.cn, cw = wc * 32 + 8 * fq;
        PG8_LAS float* const pw = part + rl0 * 8 + wc; PG8_LAS float* const p0 = part + rl0 * 8;
#pragma unroll
        for (int ai = 0; ai < 2; ++ai)
#pragma unroll
            for (int m = 0; m < 4; ++m)
#pragma unroll
                for (int bj = 0; bj < 2; ++bj) { const f32x4 v0 = acc[ai][bj][m][0], v1 = acc[ai][bj][m][1];
                    float q = (v0[0] * v0[0] + v0[1] * v0[1]) + (v0[2] * v0[2] + v0[3] * v0[3]) + (v1[0] * v1[0] + v1[1] * v1[1]) + (v1[2] * v1[2] + v1[3] * v1[3]);
                    q += __shfl_xor(q, 16); q += __shfl_xor(q, 32);
                      pw[(ai * HALF + m * 16) * 8 + bj * 4] = q; }
        asm volatile("s_waitcnt lgkmcnt(0)\n\ts_barrier" ::: "memory");
        float g0[8];
#pragma unroll
        for (int e = 0; e < 8; ++e) g0[e] = g[cw + e];
#pragma unroll
        for (int ai = 0; ai < 2; ++ai)
#pragma unroll
            for (int m = 0; m < 4; ++m) { const int row = u.pm * BM + rl0 + ai * HALF + m * 16;
                const f32x4 pa = *(const PG8_LAS f32x4*)(p0 + (ai * HALF + m * 16) * 8), pb = *(const PG8_LAS f32x4*)(p0 + (ai * HALF + m * 16) * 8 + 4);
                const float kp = kpess[row];
                float rinv[2];
                rinv[0] = __builtin_amdgcn_rsqf((((pa[0] + pa[1]) + (pa[2] + pa[3])) + kp) * (1.0f / 192.0f) + EPS);
                rinv[1] = __builtin_amdgcn_rsqf((((pb[0] + pb[1]) + (pb[2] + pb[3])) + kp) * (1.0f / 192.0f) + EPS);
#pragma unroll
                for (int bj = 0; bj < 2; ++bj) { f32x4 v0 = acc[ai][bj][m][0] * rinv[bj], v1 = acc[ai][bj][m][1] * rinv[bj];
#pragma unroll
                    for (int e = 0; e < 4; ++e) { v0[e] *= g0[e]; v1[e] *= g0[4 + e]; }
                    *(u32x4*)(KM + (size_t)row * 768 + (h0 + bj) * 192 + cw) = pack8(v0, v1); }
                if (wc < 2) { const u32x4 w = *(const u32x4*)(KPR + (size_t)row * 64 + cw);
                    f32x4 a, b; a[0] = __builtin_bit_cast(float, w.x << 16); a[1] = __builtin_bit_cast(float, w.x & 0xffff0000u); a[2] = __builtin_bit_cast(float, w.y << 16); a[3] = __builtin_bit_cast(float, w.y & 0xffff0000u);
                    b[0] = __builtin_bit_cast(float, w.z << 16); b[1] = __builtin_bit_cast(float, w.z & 0xffff0000u); b[2] = __builtin_bit_cast(float, w.w << 16); b[3] = __builtin_bit_cast(float, w.w & 0xffff0000u);
#pragma unroll
                    for (int bj = 0; bj < 2; ++bj) *(u32x4*)(KM + (size_t)row * 768 + (h0 + bj) * 192 + 128 + cw) = pack8(a * rinv[bj], b * rinv[bj]); }
                asm volatile("" ::: "memory"); }
    }
};
struct EpiNull {
    static constexpr bool PERM = true, PREF = false;
    float* sink;
    __device__ __forceinline__ void operator()(f32x4 (&acc)[2][2][4][2], const Unit& u, int wr, int wc, int fr, int fq, int par) const {
        float t = 0.f;
#pragma unroll
        for (int ai = 0; ai < 2; ++ai)
#pragma unroll
            for (int bj = 0; bj < 2; ++bj)
#pragma unroll
                for (int m = 0; m < 4; ++m)
#pragma unroll
                    for (int n = 0; n < 2; ++n) t += (acc[ai][bj][m][n][0] + acc[ai][bj][m][n][1]) + (acc[ai][bj][m][n][2] + acc[ai][bj][m][n][3]);
        if (t == 12345.678f) sink[u.pm * 256 + wr * 64 + fr] = t;
    }
};
__device__ __forceinline__ float silu_mul(float g, float u) { return g * u * __builtin_amdgcn_rcpf(1.0f + __builtin_amdgcn_exp2f(-g * LOG2E)); }
template <int MODE> struct EpiProbe {
    static constexpr bool PERM = true, PREF = false;
    bf16_t* O; int ldc; const float* ss; float* sink;
    __device__ __forceinline__ void operator()(f32x4 (&acc)[2][2][4][2], const Unit& u, int wr, int wc, int fr, int fq, int par) const {
        const int row0 = u.pm * BM + wr * 64 + fr, col0 = u.cn * HALF + wc * 32 + 8 * fq; float t = 0.f;
#pragma unroll
        for (int ai = 0; ai < 2; ++ai)
#pragma unroll
            for (int m = 0; m < 4; ++m) { const int row = row0 + ai * HALF + m * 16;
                if (MODE == 2) { const float sc = row_scale16(ss, row, fq);
#pragma unroll
                    for (int e = 0; e < 4; ++e) { t += silu_mul(acc[ai][0][m][0][e] * sc, acc[ai][1][m][0][e] * sc); t += silu_mul(acc[ai][0][m][1][e] * sc, acc[ai][1][m][1][e] * sc); } }
                else { *(u32x4*)(O + (size_t)(row & 8191) * ldc + col0) = pack8(acc[ai][0][m][0] + acc[ai][1][m][0], acc[ai][0][m][1] + acc[ai][1][m][1]); } }
        if (MODE == 2 && t == 12345.678f) sink[row0] = t;
    }
};
struct EpiSwiGLU {
    static constexpr bool PERM = true, PREF = true;
    bf16_t* O; int ldc; const float* ss; int direct; PG8_LAS float* rsl; float wsc; int q8; const float* qs;
    __device__ __forceinline__ void operator()(const f32x4 (&acc)[2][2][4][2], const Unit& u, int wr, int wc, int fr, int fq, int par) const {
        const int row0 = u.pm * BM + wr * 64 + fr, col0 = u.cn * HALF + wc * 32 + 8 * fq;
#pragma unroll
        for (int ai = 0; ai < 2; ++ai)
#pragma unroll
            for (int m = 0; m < 4; ++m) { const int row = row0 + ai * HALF + m * 16; const float sc = rsl[par * 256 + wr * 64 + fr + ai * HALF + m * 16] * wsc;
                f32x4 h0, h1;
                if (q8) {
                    const float na = -sc * LOG2E, k2 = sc * sc * (127.0f / ACT_CLIP);
#pragma unroll
                    for (int e = 0; e < 4; ++e) {
                        const f32x2 g = {acc[ai][0][m][0][e], acc[ai][0][m][1][e]}, uu = {acc[ai][1][m][0][e], acc[ai][1][m][1][e]};
                        const f32x2 t = g * na; f32x2 d = {__builtin_amdgcn_exp2f(t[0]), __builtin_amdgcn_exp2f(t[1])}; d = d + 1.0f;
                        const f32x2 r = {__builtin_amdgcn_rcpf(d[0]), __builtin_amdgcn_rcpf(d[1])};
                        const f32x2 hh = __builtin_elementwise_fma((g * uu) * r, f32x2{k2, k2}, f32x2{128.0f, 128.0f}); h0[e] = hh[0]; h1[e] = hh[1]; }
                    const unsigned long long q = (unsigned long long)pk4_u8b(h0[0], h0[1], h0[2], h0[3]) | ((unsigned long long)pk4_u8b(h1[0], h1[1], h1[2], h1[3]) << 32);
                    __builtin_nontemporal_store(q, (unsigned long long*)((unsigned char*)O + (size_t)row * ldc + col0)); }
                else {
#pragma unroll
                    for (int e = 0; e < 4; ++e) { h0[e] = silu_mul(acc[ai][0][m][0][e] * sc, acc[ai][1][m][0][e] * sc); h1[e] = silu_mul(acc[ai][0][m][1][e] * sc, acc[ai][1][m][1][e] * sc); }
                    __builtin_nontemporal_store(pack8(h0, h1), (u32x4*)(O + (size_t)row * ldc + col0)); } }
    }
};
struct EpiResid {
    static constexpr bool PERM = true, PREF = false;
    bf16_t* xb; float* ss; unsigned char* x8; float wsc; const float* qstep;
    __device__ __forceinline__ void operator()(f32x4 (&acc)[2][2][4][2], const Unit& u, int wr, int wc, int fr, int fq, int par) const {
        const int row0 = u.pm * BM + wr * 64 + fr, col0 = u.cn * BM + wc * 32 + 8 * fq;
#pragma unroll
        for (int ai = 0; ai < 2; ++ai)
#pragma unroll
            for (int m = 0; m < 4; ++m) { const int row = row0 + ai * HALF + m * 16; const size_t off = (size_t)row * DM + col0; float q = 0.f;
#pragma unroll
                for (int bj = 0; bj < 2; ++bj) { const u32x4 w = *(const u32x4*)(xb + off + bj * HALF);
                    f32x4 a, b;
                    a[0] = __builtin_bit_cast(float, w.x << 16); a[1] = __builtin_bit_cast(float, w.x & 0xffff0000u); a[2] = __builtin_bit_cast(float, w.y << 16); a[3] = __builtin_bit_cast(float, w.y & 0xffff0000u);
                    b[0] = __builtin_bit_cast(float, w.z << 16); b[1] = __builtin_bit_cast(float, w.z & 0xffff0000u); b[2] = __builtin_bit_cast(float, w.w << 16); b[3] = __builtin_bit_cast(float, w.w & 0xffff0000u);
                    f32x4 v0, v1;
#pragma unroll
                    for (int e = 0; e < 4; ++e) { v0[e] = a[e] + acc[ai][bj][m][0][e] * wsc; v1[e] = b[e] + acc[ai][bj][m][1][e] * wsc; }
                    *(u32x4*)(xb + off + bj * HALF) = pack8(v0, v1);
                    if (qstep) { const float qi = __builtin_amdgcn_rcpf(qstep[row]);
                        *(unsigned long long*)(x8 + off + bj * HALF) = (unsigned long long)pk4_i8(v0[0] * qi, v0[1] * qi, v0[2] * qi, v0[3] * qi) | ((unsigned long long)pk4_i8(v1[0] * qi, v1[1] * qi, v1[2] * qi, v1[3] * qi) << 32); }
                    else if (x8) { int w0 = __builtin_amdgcn_cvt_pk_fp8_f32(v0[0], v0[1], 0, false); w0 = __builtin_amdgcn_cvt_pk_fp8_f32(v0[2], v0[3], w0, true);
                        int w1 = __builtin_amdgcn_cvt_pk_fp8_f32(v1[0], v1[1], 0, false); w1 = __builtin_amdgcn_cvt_pk_fp8_f32(v1[2], v1[3], w1, true);
                        *(unsigned long long*)(x8 + off + bj * HALF) = (unsigned long long)(unsigned)w0 | ((unsigned long long)(unsigned)w1 << 32); }
                    q += (v0[0] * v0[0] + v0[1] * v0[1]) + (v0[2] * v0[2] + v0[3] * v0[3]) + (v1[0] * v1[0] + v1[1] * v1[1]) + (v1[2] * v1[2] + v1[3] * v1[3]); }
                q += __shfl_xor(q, 16); q += __shfl_xor(q, 32);
                if (fq == 0) ss[(size_t)row * 16 + u.cn * 4 + wc] = q; }
    }
};


template <class Epi, class Sched, bool ALIGN_EPI = true, int QM = 0>
__device__ __forceinline__ void gemm_phase(PG8_LAS unsigned char* lds, const Gemm g, const Sched& S, const Epi& E) {
    int tid_ = threadIdx.x; asm volatile("" : "+v"(tid_));
    const int tid = tid_, wid = __builtin_amdgcn_readfirstlane(tid >> 6), lane = tid & 63, wr = wid >> 2, wc = wid & 3, fr = lane & 15, fq = lane >> 4;
    int K_ = g.K, lda_ = g.lda, ldb_ = g.ldb ? g.ldb : g.K; asm volatile("" : "+s"(K_), "+s"(lda_), "+s"(ldb_));
    const int K = K_, nt = K / BK, lda = lda_, ldb = ldb_;
    unsigned voffA[2], voffB[2];
#pragma unroll
    for (int i = 0; i < 2; ++i) { int R, C; stage_rc(tid * 16 + i * 8192, R, C); const int Rb = Epi::PERM ? ((R & ~31) + perm32(R & 31)) : R;
        voffA[i] = (unsigned)(R * lda + C) * 2u; voffB[i] = (unsigned)(Rb * ldb + C) * 2u; }
    const size_t kstep = (size_t)(BK * 2);
    const size_t hstepA = (size_t)HALF * lda * 2, tstepA = 2 * hstepA, hstepB = (size_t)HALF * ldb * 2, tstepB = 2 * hstepB;
    const unsigned ldsw = (unsigned)wid * 1024u;
    const int aoff = lds_byte(wr * 64 + fr, fq * 8), boff = lds_byte(wc * 32 + fr, fq * 8);
#define PG8_SA(b, h) (((b) * 2 + (h)) * HTB)
#define PG8_SB(b, h) ((4 + (b) * 2 + (h)) * HTB)
#define PG8_STAGE(bufoff, gbase, voff) do { _Pragma("unroll") for (int _i = 0; _i < 2; ++_i) \
        __builtin_amdgcn_global_load_lds((const unsigned*)((const char*)(gbase) + (voff)[_i]), (PG8_LAS unsigned*)(lds + (bufoff) + ldsw + _i * 8192), 16, 0, 0); } while (0)
#define PG8_LDA(dst, b, h) do { _Pragma("unroll") for (int m = 0; m < 4; ++m) _Pragma("unroll") for (int k = 0; k < 2; ++k) dst[m][k] = *(const PG8_LAS bf16x8*)(lds + PG8_SA(b, h) + aoff + m * 2048 + k * 1024); } while (0)
#define PG8_LDB(dst, b, h) do { _Pragma("unroll") for (int n = 0; n < 2; ++n) _Pragma("unroll") for (int k = 0; k < 2; ++k) dst[n][k] = *(const PG8_LAS bf16x8*)(lds + PG8_SB(b, h) + boff + n * 2048 + k * 1024); } while (0)
#define PG8_CAT8(x0, x1) __builtin_shufflevector(__builtin_bit_cast(i32x4, x0), __builtin_bit_cast(i32x4, x1), 0, 1, 2, 3, 4, 5, 6, 7)
#define PG8_MMA(ai, bj, At, Bt) do { __builtin_amdgcn_s_setprio(1); _Pragma("unroll") for (int m = 0; m < 4; ++m) _Pragma("unroll") for (int n = 0; n < 2; ++n) { \
        if constexpr (QM == 1) { const i32x8 b8_ = PG8_CAT8(Bt[n][0], Bt[n][1]), a8_ = PG8_CAT8(At[m][0], At[m][1]); asm volatile("v_mfma_f32_16x16x128_f8f6f4 %0, %1, %2, %0" : "+v"(acc[ai][bj][m][n]) : "v"(b8_), "v"(a8_)); } \
        else if constexpr (QM == 2) { _Pragma("unroll") for (int k = 0; k < 2; ++k) acc[ai][bj][m][n] = __builtin_bit_cast(f32x4, __builtin_amdgcn_mfma_i32_16x16x64_i8(__builtin_bit_cast(i32x4, Bt[n][k]), __builtin_bit_cast(i32x4, At[m][k]), __builtin_bit_cast(i32x4, acc[ai][bj][m][n]), 0, 0, 0)); } \
        else { _Pragma("unroll") for (int k = 0; k < 2; ++k) acc[ai][bj][m][n] = __builtin_amdgcn_mfma_f32_16x16x32_bf16(Bt[n][k], At[m][k], acc[ai][bj][m][n], 0, 0, 0); } } \
        __builtin_amdgcn_s_setprio(0); } while (0)
#define PG8_WAIT_V(n) asm volatile("s_waitcnt vmcnt(" #n ")" ::: "memory")
#define PG8_WAIT_L(n) asm volatile("s_waitcnt lgkmcnt(" #n ")" ::: "memory")
#define PG8_BAR __builtin_amdgcn_s_barrier()
#define PG8_WAIT_L_G1 asm volatile("s_cmp_eq_u32 %0, 0\n\ts_cbranch_scc1 1f\n\ts_waitcnt lgkmcnt(0)\n1:" :: "s"(wr) : "memory", "scc")
#define PG8_SCHED __builtin_amdgcn_sched_barrier(0)
    Unit cur, nxt; int ui = 0;
    if (!S.next(0, cur)) return;
    if constexpr (Epi::PREF) { RsPref r0_; float e0_ = 1.0f; rs_issue(r0_, e0_, E.ss, E.direct, cur.pm, tid, E.qs); rs_commit(r0_, e0_, E.direct, E.rsl, 0, tid, E.qs); }
    f32x4 acc[2][2][4][2];
#pragma unroll
    for (int a = 0; a < 2; ++a)
#pragma unroll
        for (int b = 0; b < 2; ++b)
#pragma unroll
            for (int m = 0; m < 4; ++m)
#pragma unroll
                for (int n = 0; n < 2; ++n) { f32x2 z0_, z1_; asm volatile("v_pk_mov_b32 %0, 0, 0" : "=v"(z0_)); asm volatile("v_pk_mov_b32 %0, 0, 0" : "=v"(z1_)); acc[a][b][m][n] = __builtin_shufflevector(z0_, z1_, 0, 1, 2, 3); }
    bf16x8 At[4][2], B0[2][2], B1[2][2];
    const char* cA = (const char*)g.A + (size_t)cur.pm * tstepA; const char* cB = (const char*)g.Bt + (size_t)cur.pn * tstepB;
    PG8_STAGE(PG8_SB(0, 0), cB, voffB); PG8_STAGE(PG8_SB(0, 1), cB + hstepB, voffB); PG8_STAGE(PG8_SA(0, 0), cA, voffA); PG8_STAGE(PG8_SA(0, 1), cA + hstepA, voffA);
    if (wr == 1) PG8_BAR;
    PG8_WAIT_V(2); PG8_BAR;
    PG8_STAGE(PG8_SB(1, 0), cB + kstep, voffB); PG8_STAGE(PG8_SA(1, 0), cA + kstep, voffA); PG8_STAGE(PG8_SB(1, 1), cB + hstepB + kstep, voffB);
    PG8_WAIT_V(6); PG8_BAR;
    for (;;) {
        const bool has_next = S.next(ui + 1, nxt);
        const char* nA = has_next ? (const char*)g.A + (size_t)nxt.pm * tstepA : cA; const char* nB = has_next ? (const char*)g.Bt + (size_t)nxt.pn * tstepB : cB;
        for (int t = 0; t < nt; t += 2) {
            const bool last = (t == nt - 2);
            const char* a1 = cA + (size_t)(t + 1) * kstep;
            const char* a2 = last ? nA : cA + (size_t)(t + 2) * kstep; const char* b2 = last ? nB : cB + (size_t)(t + 2) * kstep;
            const char* a3 = a2 + kstep; const char* b3 = b2 + kstep;
            PG8_LDB(B0, 0, 0); PG8_LDB(B1, 0, 1); PG8_SCHED; PG8_LDA(At, 0, 0); PG8_STAGE(PG8_SA(1, 1), a1 + hstepA, voffA);
            PG8_WAIT_V(8); PG8_WAIT_L_G1; PG8_BAR; PG8_MMA(0, 0, At, B0); PG8_MMA(0, 1, At, B1); PG8_BAR; PG8_SCHED;
            PG8_LDA(At, 0, 1); PG8_STAGE(PG8_SB(0, 0), b2, voffB); PG8_STAGE(PG8_SB(0, 1), b2 + hstepB, voffB); PG8_STAGE(PG8_SA(0, 0), a2, voffA);
            PG8_WAIT_V(8); PG8_WAIT_L_G1; PG8_BAR; PG8_MMA(1, 0, At, B0); PG8_MMA(1, 1, At, B1); PG8_BAR; PG8_SCHED;
            PG8_LDB(B0, 1, 0); PG8_LDB(B1, 1, 1); PG8_SCHED; PG8_LDA(At, 1, 0); PG8_STAGE(PG8_SA(0, 1), a2 + hstepA, voffA);
            PG8_WAIT_V(8); PG8_WAIT_L_G1; PG8_BAR; PG8_MMA(0, 0, At, B0); PG8_MMA(0, 1, At, B1); PG8_BAR; PG8_SCHED;
            PG8_LDA(At, 1, 1); PG8_STAGE(PG8_SB(1, 0), b3, voffB); PG8_STAGE(PG8_SB(1, 1), b3 + hstepB, voffB); PG8_STAGE(PG8_SA(1, 0), a3, voffA);
            PG8_WAIT_V(8); PG8_WAIT_L_G1; PG8_BAR; PG8_MMA(1, 0, At, B0); PG8_MMA(1, 1, At, B1); PG8_BAR; PG8_SCHED;
        }
        if constexpr (QM == 2) {
#pragma unroll
            for (int a = 0; a < 2; ++a)
#pragma unroll
                for (int b = 0; b < 2; ++b)
#pragma unroll
                    for (int m = 0; m < 4; ++m)
#pragma unroll
                        for (int n = 0; n < 2; ++n) { const i32x4 t_ = __builtin_bit_cast(i32x4, acc[a][b][m][n]); acc[a][b][m][n] = (f32x4){(float)t_[0], (float)t_[1], (float)t_[2], (float)t_[3]}; } }
        if constexpr (QM == 1) asm volatile("s_nop 15\n\ts_nop 15" ::: "memory");
        if constexpr (ALIGN_EPI) { if (wr == 0) PG8_BAR; }
        RsPref rp_; float ep_ = 1.0f; if constexpr (Epi::PREF) { if (has_next) rs_issue(rp_, ep_, E.ss, E.direct, nxt.pm, tid, E.qs); }
        { int fr_ = fr, fq_ = fq; asm volatile("" : "+v"(fr_), "+v"(fq_)); E(acc, cur, wr, wc, fr_, fq_, ui & 1); }
        if constexpr (Epi::PREF) { if (has_next) rs_commit(rp_, ep_, E.direct, E.rsl, (ui + 1) & 1, tid, E.qs); }
        if (!has_next) break;
#pragma unroll
        for (int a = 0; a < 2; ++a)
#pragma unroll
            for (int b = 0; b < 2; ++b)
#pragma unroll
                for (int m = 0; m < 4; ++m)
#pragma unroll
                    for (int n = 0; n < 2; ++n) { f32x2 z0_, z1_; asm volatile("v_pk_mov_b32 %0, 0, 0" : "=v"(z0_)); asm volatile("v_pk_mov_b32 %0, 0, 0" : "=v"(z1_)); acc[a][b][m][n] = __builtin_shufflevector(z0_, z1_, 0, 1, 2, 3); }
        cur = nxt; cA = nA; cB = nB; ++ui;
        if constexpr (ALIGN_EPI) { if (wr == 1) PG8_BAR; }
    }
    PG8_WAIT_V(0);
    if constexpr (!ALIGN_EPI) { if (wr == 0) PG8_BAR; }
    PG8_BAR;
#undef PG8_SA
#undef PG8_SB
#undef PG8_STAGE
#undef PG8_LDA
#undef PG8_LDB
#undef PG8_MMA
#undef PG8_WAIT_V
#undef PG8_WAIT_L
#undef PG8_BAR
#undef PG8_SCHED
}
}

namespace att {
typedef unsigned short bf16;
typedef short bf16x8 __attribute__((ext_vector_type(8)));
typedef short s16x4 __attribute__((ext_vector_type(4)));
typedef float f32x16 __attribute__((ext_vector_type(16)));
typedef float f32x4 __attribute__((ext_vector_type(4)));
typedef unsigned u32x4 __attribute__((ext_vector_type(4)));
constexpr int NW = 8, QBLK = 32, KVBLK = 64, QB = 256;
constexpr int SHM_V = KVBLK * 128 * 2;
#define SBAR() __builtin_amdgcn_sched_barrier(0)
__device__ __forceinline__ int v_st(int k, int c) { const int kk = (k & ~0xC) | ((k & 4) << 1) | ((k & 8) >> 1); return ((kk >> 3) * 4 + (c >> 5)) * 512 + ((kk & 7) * 32 + (c & 31)) * 2; }
__device__ __forceinline__ int v_rd_base(int lane) { return ((lane & 3) << 3) | (((lane >> 2) & 3) << 6) | (((lane >> 4) & 1) << 5) | (((lane >> 5) & 1) << 8); }
constexpr int v_rd_off(int d0, int ks, int half) { return d0 * 512 + ks * 4096 + half * 2048; }
__device__ __forceinline__ int crow(int r, int hi) { return (r & 3) + 8 * (r >> 2) + 4 * hi; }
__device__ __forceinline__ unsigned cvtpk(float lo, float hi) { unsigned r; asm volatile("v_cvt_pk_bf16_f32 %0, %1, %2" : "=v"(r) : "v"(lo), "v"(hi)); return r; }

__device__ __forceinline__ void mask_tile(f32x16& p0, f32x16& p1, int dq) {
    const float NEG = -__builtin_inff();
#pragma unroll
    for (int r = 0; r < 16; ++r) { const int c = (r & 3) + 8 * (r >> 2); if (c > dq) p0[r] = NEG; if (c + 32 > dq) p1[r] = NEG; }
}
__device__ __forceinline__ void expA(f32x16& p0) {
#pragma unroll
    for (int r = 0; r < 16; ++r) p0[r] = __builtin_amdgcn_exp2f(p0[r]);
}
__device__ __forceinline__ void finishSM(f32x16& p0, f32x16& p1, float& l_reg, bf16x8& pa0, bf16x8& pa1, bf16x8& pa2, bf16x8& pa3) {
#pragma unroll
    for (int r = 0; r < 16; ++r) p1[r] = __builtin_amdgcn_exp2f(p1[r]);
    float ps = 0;
#pragma unroll
    for (int r = 0; r < 16; ++r) ps += p0[r];
#pragma unroll
    for (int r = 0; r < 16; ++r) ps += p1[r];
    l_reg += ps;
#define PK4(P, B_, OUT) do { unsigned a0 = cvtpk(P[B_+0], P[B_+1]), a1 = cvtpk(P[B_+2], P[B_+3]);                          \
        unsigned b0 = cvtpk(P[B_+4], P[B_+5]), b1 = cvtpk(P[B_+6], P[B_+7]);                                             \
        auto r0 = __builtin_amdgcn_permlane32_swap(a0, b0, false, false); auto r1 = __builtin_amdgcn_permlane32_swap(a1, b1, false, false); \
        u32x4 w = {r0[0], r1[0], r0[1], r1[1]}; OUT = *reinterpret_cast<bf16x8*>(&w); } while (0)
    PK4(p0, 0, pa0); PK4(p0, 8, pa1); PK4(p1, 0, pa2); PK4(p1, 8, pa3);
#undef PK4
}
template <int DQK> __device__ __forceinline__ int k_off(int row, int chunk) { return row * (DQK * 2) + (((chunk & ~7) | ((chunk & 7) ^ ((row >> 1) & 7))) << 4); }
template <int DQK>
__device__ __forceinline__ void qkt(f32x16& p0, f32x16& p1, const __attribute__((address_space(3))) char* Kbuf, int r32, int hi, const bf16x8* qr) {
    p0 = f32x16{}; p1 = f32x16{};
    const __attribute__((address_space(3))) char* kb[4];
#pragma unroll
    for (int dd = 0; dd < 4; ++dd) kb[dd] = Kbuf + k_off<DQK>(r32, 2 * dd + hi);
#pragma unroll
    for (int d0 = 0; d0 < DQK / 16; ++d0) { const __attribute__((address_space(3))) char* a = kb[d0 & 3] + (d0 >> 2) * 128;
        bf16x8 b0 = *(const __attribute__((address_space(3))) bf16x8*)(a);
        bf16x8 b1 = *(const __attribute__((address_space(3))) bf16x8*)(a + 32 * DQK * 2);
        p0 = __builtin_amdgcn_mfma_f32_32x32x16_bf16(b0, qr[d0], p0, 0, 0, 0); p1 = __builtin_amdgcn_mfma_f32_32x32x16_bf16(b1, qr[d0], p1, 0, 0, 0);
        if ((d0 & 3) == 3) SBAR(); }
}
__device__ __forceinline__ void pv_tile(f32x16* o, int vb0, bf16x8 pa0, bf16x8 pa1, bf16x8 pa2, bf16x8 pa3) {
#define TRRD(dst, off) asm volatile("ds_read_b64_tr_b16 %0, %1 offset:%2" : "=&v"(dst) : "v"(vb0), "i"(off) : "memory")
#define PV_D0(d0) do { s16x4 l0, l1, l2, l3, h0, h1, h2, h3; constexpr int b_ = v_rd_off(d0, 0, 0); \
        TRRD(l0, b_); TRRD(h0, b_ + 2048); TRRD(l1, b_ + 4096); TRRD(h1, b_ + 6144); TRRD(l2, b_ + 8192); TRRD(h2, b_ + 10240); TRRD(l3, b_ + 12288); TRRD(h3, b_ + 14336); \
        asm volatile("s_waitcnt lgkmcnt(0)" ::: "memory"); SBAR();   \
        o[d0] = __builtin_amdgcn_mfma_f32_32x32x16_bf16(pa0, (bf16x8){l0[0], l0[1], l0[2], l0[3], h0[0], h0[1], h0[2], h0[3]}, o[d0], 0, 0, 0);   \
        o[d0] = __builtin_amdgcn_mfma_f32_32x32x16_bf16(pa1, (bf16x8){l1[0], l1[1], l1[2], l1[3], h1[0], h1[1], h1[2], h1[3]}, o[d0], 0, 0, 0);   \
        o[d0] = __builtin_amdgcn_mfma_f32_32x32x16_bf16(pa2, (bf16x8){l2[0], l2[1], l2[2], l2[3], h2[0], h2[1], h2[2], h2[3]}, o[d0], 0, 0, 0);   \
        o[d0] = __builtin_amdgcn_mfma_f32_32x32x16_bf16(pa3, (bf16x8){l3[0], l3[1], l3[2], l3[3], h3[0], h3[1], h3[2], h3[3]}, o[d0], 0, 0, 0); } while (0)
    PV_D0(0); PV_D0(1); PV_D0(2); PV_D0(3);
#undef PV_D0
#undef TRRD
}
constexpr int NBUF = 3;
template <int DQK> constexpr int lds_bytes() { return NBUF * SHM_V + NBUF * KVBLK * DQK * 2 + NW * 64 * 4; }

struct AttnOut { bf16* Ob; float* Of; int opb, opf; float lam, post; const float* gsub; float qinv; };
template <int DQK, int MODE, int qp, int kp, int vp, bool PIPE>
__device__ __forceinline__ void attn_unit(const bf16* Q, const bf16* K, const bf16* V, int qb, const AttnOut& AO, char* lds, __attribute__((address_space(3))) unsigned char* ldsl) {
    constexpr int SHM_K = KVBLK * DQK * 2, NKP = SHM_K / 8192, NVP = 2, NPW = NKP + NVP, ND = DQK / 16;
    constexpr int K_BASE = NBUF * SHM_V, WS_BASE = K_BASE + NBUF * SHM_K;
    int tid_ = threadIdx.x; asm volatile("" : "+v"(tid_));
    const int tid = tid_, wid = __builtin_amdgcn_readfirstlane(tid >> 6), lane = tid & 63, r32 = lane & 31, hi = lane >> 5;
    const int q0 = qb * QB, NT = (q0 + QB) / KVBLK;
    const int qlo = q0 + wid * QBLK, qm = qlo + r32 - 4 * hi;
    __attribute__((address_space(3))) float* ws = (__attribute__((address_space(3))) float*)(ldsl + WS_BASE) + wid * 64;
    float l_reg = 0; f32x16 o[4] = {};
    unsigned kgo[NKP], vgo[NVP];
#pragma unroll
    for (int i = 0; i < NKP; ++i) { const int ob = (wid + 8 * i) * 1024 + lane * 16, row = ob / (DQK * 2), sw = (ob % (DQK * 2)) >> 4, ch = (sw & ~7) | ((sw & 7) ^ ((row >> 1) & 7));
        kgo[i] = (unsigned)(row * kp + ch * 8) * 2u; }
#pragma unroll
    for (int j = 0; j < NVP; ++j) { const int ob = (wid + 8 * j) * 1024 + lane * 16, sub = ob >> 9, within = ob & 511, kk = (sub >> 2) * 8 + (within >> 6), c = (sub & 3) * 32 + ((within & 63) >> 1);
        const int k = (kk & ~0xC) | ((kk & 4) << 1) | ((kk & 8) >> 1);
        vgo[j] = (unsigned)(k * vp + c) * 2u; }
    const int vb0 = (int)(uintptr_t)lds + v_rd_base(lane);
#define DMA_TILE(t, b) do { const char* Kt_ = (const char*)K + (size_t)(t) * (KVBLK * kp * 2); const char* Vt_ = (const char*)V + (size_t)(t) * (KVBLK * vp * 2); \
        _Pragma("unroll") for (int i_ = 0; i_ < NKP; ++i_) __builtin_amdgcn_global_load_lds((const unsigned*)(Kt_ + kgo[i_]), (__attribute__((address_space(3))) unsigned*)(ldsl + K_BASE + (b) * SHM_K + (wid + 8 * i_) * 1024), 16, 0, 0); \
        _Pragma("unroll") for (int j_ = 0; j_ < NVP; ++j_) __builtin_amdgcn_global_load_lds((const unsigned*)(Vt_ + vgo[j_]), (__attribute__((address_space(3))) unsigned*)(ldsl + (b) * SHM_V + (wid + 8 * j_) * 1024), 16, 0, 0); } while (0)
#define MASKT(P0_, P1_, t) do { const int kb_ = (t) * KVBLK; if (kb_ + KVBLK - 1 > qlo) mask_tile(P0_, P1_, qm - kb_); } while (0)
    bf16x8 qr[ND];
#pragma unroll
    for (int d0 = 0; d0 < ND; ++d0) qr[d0] = *(const bf16x8*)(Q + (size_t)(qlo + r32) * qp + d0 * 16 + hi * 8);
    DMA_TILE(0, 0); DMA_TILE(1, 1);
    asm volatile("s_waitcnt vmcnt(0)\n\ts_barrier" ::: "memory");
    bf16x8 pa0, pa1, pa2, pa3;
#define ABAR() asm volatile("s_waitcnt lgkmcnt(0)\n\ts_barrier" ::: "memory")
#define VMW_BAR(n) asm volatile("s_waitcnt vmcnt(%0) lgkmcnt(0)\n\ts_barrier" :: "n"(n) : "memory")
    f32x16 pA0, pA1, pB0, pB1;
    int bc = 0, bk = 1, bn = 2;
#define ROT3() do { const int t_ = bc; bc = bk; bk = bn; bn = t_; } while (0)
#define KBUF(b) ((const __attribute__((address_space(3))) char*)ldsl + K_BASE + (b) * SHM_K)
#define STEP(PX0, PX1, PY0, PY1, t) do {                                                      \
        if ((t) + 2 < NT) DMA_TILE((t) + 2, bn);                                               \
        SBAR(); qkt<DQK>(PX0, PX1, KBUF(bk), r32, hi, qr);                                      \
        finishSM(PY0, PY1, l_reg, pa0, pa1, pa2, pa3); SBAR();                                  \
        pv_tile(o, vb0 + bc * SHM_V, pa0, pa1, pa2, pa3);                                      \
        MASKT(PX0, PX1, (t) + 1); expA(PX0);                                                   \
        VMW_BAR(0); ROT3(); } while (0)
    if constexpr (PIPE) {
    qkt<DQK>(pA0, pA1, KBUF(0), r32, hi, qr);
    MASKT(pA0, pA1, 0); expA(pA0);
    for (int t = 0; t + 2 < NT; t += 2) {
        STEP(pB0, pB1, pA0, pA1, t);
        STEP(pA0, pA1, pB0, pB1, t + 1);
    }
    STEP(pB0, pB1, pA0, pA1, NT - 2);
    finishSM(pB0, pB1, l_reg, pa0, pa1, pa2, pa3); SBAR();
    pv_tile(o, vb0 + bc * SHM_V, pa0, pa1, pa2, pa3);
    } else {
    for (int t = 0; t < NT; ++t) {
        if (t + 2 < NT) DMA_TILE(t + 2, bn);
        qkt<DQK>(pA0, pA1, KBUF(bc), r32, hi, qr);
        MASKT(pA0, pA1, t); expA(pA0);
        finishSM(pA0, pA1, l_reg, pa0, pa1, pa2, pa3); SBAR();
        pv_tile(o, vb0 + bc * SHM_V, pa0, pa1, pa2, pa3);
        if (t + 2 < NT) VMW_BAR(NPW); else VMW_BAR(0);
        ROT3();
    }
    }
    { auto rr = __builtin_amdgcn_permlane32_swap(__float_as_uint(l_reg), __float_as_uint(l_reg), false, false); l_reg = __uint_as_float(rr[0]) + __uint_as_float(rr[1]); }
    if (hi == 0) ws[r32] = l_reg;
    asm volatile("s_waitcnt lgkmcnt(0)" ::: "memory");
    float rli[16];
#pragma unroll
    for (int r = 0; r < 16; ++r) rli[r] = __builtin_amdgcn_rcpf(ws[crow(r, hi)]);
    asm volatile("s_waitcnt lgkmcnt(0)\n\ts_barrier" ::: "memory");
    __attribute__((address_space(3))) unsigned short* stg = (__attribute__((address_space(3))) unsigned short*)(ldsl + wid * 8192);
#define STORE_STAGED(Ow_, pitch_) do { asm volatile("s_waitcnt lgkmcnt(0)" ::: "memory"); \
        _Pragma("unroll") for (int i_ = 0; i_ < 8; ++i_) { const int rw_ = i_ * 4 + (lane >> 4), ch_ = lane & 15; \
            const u32x4 v_ = *(const __attribute__((address_space(3))) u32x4*)(stg + rw_ * 128 + ch_ * 8); *(u32x4*)((Ow_) + (size_t)rw_ * (pitch_) + ch_ * 8) = v_; } } while (0)
    __attribute__((address_space(3))) unsigned char* stg8 = (__attribute__((address_space(3))) unsigned char*)(ldsl + wid * 8192);
#define STORE_STAGED8(Ow_, pitch_) do { asm volatile("s_waitcnt lgkmcnt(0)" ::: "memory"); \
        _Pragma("unroll") for (int i_ = 0; i_ < 4; ++i_) { const int rw_ = i_ * 8 + (lane >> 3), ch_ = lane & 7; \
            const u32x4 v_ = *(const __attribute__((address_space(3))) u32x4*)(stg8 + rw_ * 128 + ch_ * 16); *(u32x4*)((Ow_) + (size_t)rw_ * (pitch_) + ch_ * 16) = v_; } } while (0)
#define I8B(x_) ((unsigned char)((__builtin_amdgcn_cvt_pk_u8_f32((x_) + 128.0f, 0, 0u) ^ 0x80u) & 0xffu))
    if constexpr (MODE == 0) {
        bf16* Ow = AO.Ob + (size_t)qlo * AO.opb;
#pragma unroll
        for (int r = 0; r < 16; ++r) { const int orow = crow(r, hi);
#pragma unroll
            for (int d0 = 0; d0 < 4; ++d0) { const float v = o[d0][r] * rli[r]; if (I8_AO) stg8[orow * 128 + d0 * 32 + r32] = I8B(v * AO.qinv); else stg[orow * 128 + d0 * 32 + r32] = (unsigned short)(cvtpk(v, v) & 0xffffu); } }
        if (I8_AO) STORE_STAGED8((unsigned char*)AO.Ob + (size_t)qlo * AO.opb, AO.opb); else STORE_STAGED(Ow, AO.opb);
    } else if constexpr (MODE == 1) {
        u32x4* Ow = (u32x4*)AO.Of + (size_t)wid * 512 + lane;
#pragma unroll
        for (int jj = 0; jj < 8; ++jj) { const int r4 = (jj >> 1) * 4, da = (jj & 1) * 2, db = da + 1; u32x4 w;
            w.x = cvtpk(o[da][r4] * rli[r4], o[da][r4 + 1] * rli[r4 + 1]); w.y = cvtpk(o[da][r4 + 2] * rli[r4 + 2], o[da][r4 + 3] * rli[r4 + 3]);
            w.z = cvtpk(o[db][r4] * rli[r4], o[db][r4 + 1] * rli[r4 + 1]); w.w = cvtpk(o[db][r4 + 2] * rli[r4 + 2], o[db][r4 + 3] * rli[r4 + 3]);
            Ow[jj * 64] = w; }
    } else {
        const u32x4* O1 = (const u32x4*)AO.Of + (size_t)wid * 512 + lane; bf16* Ow = AO.Ob + (size_t)qlo * AO.opb;
        f32x4 o1v[16];
#pragma unroll
        for (int jj = 0; jj < 8; ++jj) { const u32x4 w = O1[jj * 64]; const int j0 = (jj >> 1) * 4 + (jj & 1) * 2;
            o1v[j0] = (f32x4){__builtin_bit_cast(float, w.x << 16), __builtin_bit_cast(float, w.x & 0xffff0000u), __builtin_bit_cast(float, w.y << 16), __builtin_bit_cast(float, w.y & 0xffff0000u)};
            o1v[j0 + 1] = (f32x4){__builtin_bit_cast(float, w.z << 16), __builtin_bit_cast(float, w.z & 0xffff0000u), __builtin_bit_cast(float, w.w << 16), __builtin_bit_cast(float, w.w & 0xffff0000u)}; }
        float gs[4];
#pragma unroll
        for (int d0 = 0; d0 < 4; ++d0) gs[d0] = AO.gsub[d0 * 32 + r32] * AO.post;
#pragma unroll
        for (int r = 0; r < 16; ++r) { const int orow = crow(r, hi); float v[4]; float q = 0.f;
#pragma unroll
            for (int d0 = 0; d0 < 4; ++d0) { v[d0] = o1v[(r >> 2) * 4 + d0][r & 3] - AO.lam * (o[d0][r] * rli[r]); q += v[d0] * v[d0]; }
            q += __shfl_xor(q, 1); q += __shfl_xor(q, 2); q += __shfl_xor(q, 4); q += __shfl_xor(q, 8); q += __shfl_xor(q, 16);
            const float rs = __builtin_amdgcn_rsqf(q * (1.0f / 128.0f) + EPS);
#pragma unroll
            for (int d0 = 0; d0 < 4; ++d0) { const float y = v[d0] * rs * gs[d0]; if (I8_AO) stg8[orow * 128 + d0 * 32 + r32] = I8B(y * AO.qinv); else stg[orow * 128 + d0 * 32 + r32] = (unsigned short)(cvtpk(y, y) & 0xffffu); } }
        if (I8_AO) STORE_STAGED8((unsigned char*)AO.Ob + (size_t)qlo * AO.opb, AO.opb); else STORE_STAGED(Ow, AO.opb);
    }
#undef STORE_STAGED
#undef STORE_STAGED8
#undef I8B
    asm volatile("s_waitcnt vmcnt(0) lgkmcnt(0)\n\ts_barrier" ::: "memory");
#undef DMA_TILE
#undef MASKT
#undef ABAR
#undef VMW_BAR
#undef ROT3
#undef KBUF
#undef STEP
}
#undef SBAR
}

#define GAS __attribute__((address_space(1)))
#define LAS __attribute__((address_space(3)))
typedef unsigned short bf16;
typedef unsigned v4u __attribute__((ext_vector_type(4)));
typedef float f32x4 __attribute__((ext_vector_type(4)));
typedef GAS unsigned gu32;
#define RLX_AGENT __ATOMIC_RELAXED, __HIP_MEMORY_SCOPE_AGENT
#define LDS_WAIT() asm volatile("s_waitcnt lgkmcnt(0)" ::: "memory")
__device__ __forceinline__ unsigned f2bf(float f) { unsigned u = __builtin_bit_cast(unsigned, f); return (u + 0x7fffu + ((u >> 16) & 1u)) >> 16; }
__device__ __forceinline__ unsigned pk2(float lo, float hi) { return f2bf(lo) | (f2bf(hi) << 16); }
__device__ __forceinline__ float bf2f(unsigned short b) { return __builtin_bit_cast(float, (unsigned)b << 16); }
__device__ __forceinline__ void unpack8(v4u w, float* v) {
    v[0] = __builtin_bit_cast(float, w.x << 16); v[1] = __builtin_bit_cast(float, w.x & 0xffff0000u); v[2] = __builtin_bit_cast(float, w.y << 16); v[3] = __builtin_bit_cast(float, w.y & 0xffff0000u);
    v[4] = __builtin_bit_cast(float, w.z << 16); v[5] = __builtin_bit_cast(float, w.z & 0xffff0000u); v[6] = __builtin_bit_cast(float, w.w << 16); v[7] = __builtin_bit_cast(float, w.w & 0xffff0000u);
}
__device__ __forceinline__ v4u pack8v(const float* v) { v4u w; w.x = pk2(v[0], v[1]); w.y = pk2(v[2], v[3]); w.z = pk2(v[4], v[5]); w.w = pk2(v[6], v[7]); return w; }

#define XB_TMO      128
#define XB_XCNT(j)  (256  + 64 * (j))
#define XB_XSUB(j)  (1280 + 64 * (j))
#define XB_XGEN(j)  (2304 + 64 * (j))
#define XB_TOP      3328
#define XB_TOPGEN   3392
#define XCD_BAR_WORDS 3456
#define XB_SPIN_CAP (1u << 18)
__device__ __forceinline__ unsigned xb_ld(unsigned* p)              { return __hip_atomic_load(p, __ATOMIC_RELAXED, __HIP_MEMORY_SCOPE_AGENT); }
__device__ __forceinline__ unsigned xb_add(unsigned* p, unsigned v) { return __hip_atomic_fetch_add(p, v, __ATOMIC_RELAXED, __HIP_MEMORY_SCOPE_AGENT); }
__device__ __forceinline__ unsigned xb_xcc_id() { return (unsigned)__builtin_amdgcn_s_getreg((3 << 11) | 20) & 0xFu; }
#define XB_SPIN(cond, bar) do { unsigned _sp = 0; while (cond) { __builtin_amdgcn_s_sleep(1); \
    if ((++_sp & 255u) == 0u) { if (xb_ld(&(bar)[XB_TMO])) break; if (_sp > XB_SPIN_CAP) { atomicAdd(&(bar)[XB_TMO], 1u); break; } } } } while (0)
struct XcdBarrier { unsigned* bar; unsigned x; volatile LAS unsigned* st; };
__device__ __forceinline__ XcdBarrier xcd_barrier_post(unsigned* bar, volatile LAS unsigned* st) {
    XcdBarrier b; b.bar = bar; b.x = xb_xcc_id(); b.st = st;
    if (threadIdx.x == 0) (void)xb_add(&bar[XB_XCNT(b.x)], 1u);
    return b;
}
__device__ __forceinline__ void xcd_barrier_complete(unsigned* bar, unsigned x, unsigned& nloc, unsigned& nx) {
    const unsigned G = gridDim.x * gridDim.y * gridDim.z;
    unsigned sum, cnt, mine, sp = 0u;
    for (;;) {
        sum = 0u; cnt = 0u; mine = 0u;
#pragma unroll
        for (unsigned j = 0; j < 16; ++j) { const unsigned c = xb_ld(&bar[XB_XCNT(j)]); sum += c; cnt += (c > 0u) ? 1u : 0u; mine = (j == x) ? c : mine; }
        if (sum == G) break;
        __builtin_amdgcn_s_sleep(1);
        if ((++sp & 255u) == 0u) { if (xb_ld(&bar[XB_TMO])) break; if (sp > XB_SPIN_CAP) { atomicAdd(&bar[XB_TMO], 1u); break; } }
    }
    nloc = mine > 0u ? mine : 1u; nx = cnt > 0u ? cnt : 1u;
}
__device__ __forceinline__ void xcd_barrier(const XcdBarrier& b) {
    asm volatile("s_waitcnt vmcnt(0)" ::: "memory");
    __syncthreads();
    if (threadIdx.x == 0) {
        unsigned* bar = b.bar;
        __builtin_amdgcn_s_waitcnt(0);
        unsigned nloc = b.st[0], nx = b.st[1];
        if (nloc == 0u) { xcd_barrier_complete(bar, b.x, nloc, nx); b.st[0] = nloc; b.st[1] = nx; }
        const unsigned old = xb_add(&bar[XB_XSUB(b.x)], 1u);
        const unsigned gen = old / nloc;
        if (old + 1u == (gen + 1u) * nloc) {
            __builtin_amdgcn_fence(__ATOMIC_RELEASE, "agent");
            asm volatile("s_waitcnt vmcnt(0)" ::: "memory");
            const unsigned og = xb_add(&bar[XB_TOP], 1u);
            const unsigned tg = og / nx;
            if (og + 1u == (tg + 1u) * nx) xb_add(&bar[XB_TOPGEN], 1u);
            else XB_SPIN(xb_ld(&bar[XB_TOPGEN]) == tg, bar);
            __builtin_amdgcn_fence(__ATOMIC_ACQUIRE, "agent");
            xb_add(&bar[XB_XGEN(b.x)], 1u);
            asm volatile("s_waitcnt vmcnt(0)" ::: "memory");
        } else {
            XB_SPIN(xb_ld(&bar[XB_XGEN(b.x)]) == gen, bar);
            __builtin_amdgcn_fence(__ATOMIC_ACQUIRE, "agent");
            asm volatile("s_waitcnt vmcnt(0)" ::: "memory");
        }
    }
    __syncthreads();
}

struct Args {
    const float* in[21]; float* out; unsigned char* ws; int ph_lo, ph_hi;
};
__device__ __forceinline__ float wave_sum(float v) {
#pragma unroll
    for (int o = 1; o < 64; o <<= 1) v += __shfl_xor(v, o);
    return v;
}
__device__ __forceinline__ void sincos_rev(float ang, float& s, float& c) {
    double r = (double)ang * 0.15915494309189533577; r -= __builtin_rint(r); const float f = (float)r;
    s = __builtin_amdgcn_sinf(f); c = __builtin_amdgcn_cosf(f);
}
__device__ __forceinline__ int rowmap(int mode, int n) {
    if (mode == 0) return n;
    if (mode == 1) return (n / 128) * 256 + (n % 128);
    if (mode == 2) return (n / 128) * 256 + 128 + (n % 128);
    if (mode == 5) return (n >> 8) * 128 + (n & 127);
    if (mode == 3) { const int h = n / 192, d = n % 192; return h * 256 + (d < 128 ? d : 128 + 2 * ((d - 128) & 31) + ((d - 128) >> 5)); }
    if (n < 1024) { const int d = n & 63; return d < 16 ? (n & ~63) + (d < 8 ? 2 * d : 2 * (d - 8) + 1) : n; }
    return n < 1920 ? n : 1920 + 2 * ((n - 1920) & 31) + ((n - 1920) >> 5);
}
__device__ __forceinline__ void tr_item(const float* W, int K, int N, bf16* WT, const float* gain, int mode, LAS float* scr, int item, int lane, int f8 = 0, float wq = WQ_I8, int pitch = 0) {
    const int nblk = N / 32, kb = item / nblk, nb = item % nblk, k0 = 64 * kb, n0 = 32 * nb;
    float wv[32];
#pragma unroll
    for (int i = 0; i < 32; ++i) wv[i] = __builtin_nontemporal_load(W + (size_t)(k0 + 2 * i + (lane >> 5)) * N + n0 + (lane & 31));
    if (gain) {
#pragma unroll
        for (int i = 0; i < 32; ++i) wv[i] *= gain[k0 + 2 * i + (lane >> 5)]; }
#pragma unroll
    for (int i = 0; i < 32; ++i) scr[(2 * i + (lane >> 5)) * 33 + (lane & 31)] = wv[i];
    LDS_WAIT(); asm volatile("" ::: "memory");
    const int c = lane & 7;
#pragma unroll
    for (int j = 0; j < 4; ++j) { const int n = (lane >> 3) + 8 * j; const LAS float* s = scr + (8 * c) * 33 + n;
        if (f8 == 2) { const unsigned long long q = (unsigned long long)pk4_i8(s[0 * 33] * wq, s[1 * 33] * wq, s[2 * 33] * wq, s[3 * 33] * wq) | ((unsigned long long)pk4_i8(s[4 * 33] * wq, s[5 * 33] * wq, s[6 * 33] * wq, s[7 * 33] * wq) << 32);
            *(GAS unsigned long long*)((unsigned char*)WT + (size_t)rowmap(mode, n0 + n) * (pitch ? pitch : K) + k0 + 8 * c) = q; }
        else if (f8) { int w0 = __builtin_amdgcn_cvt_pk_fp8_f32(s[0 * 33] * 64.0f, s[1 * 33] * 64.0f, 0, false); w0 = __builtin_amdgcn_cvt_pk_fp8_f32(s[2 * 33] * 64.0f, s[3 * 33] * 64.0f, w0, true);
            int w1 = __builtin_amdgcn_cvt_pk_fp8_f32(s[4 * 33] * 64.0f, s[5 * 33] * 64.0f, 0, false); w1 = __builtin_amdgcn_cvt_pk_fp8_f32(s[6 * 33] * 64.0f, s[7 * 33] * 64.0f, w1, true);
            *(GAS unsigned long long*)((unsigned char*)WT + (size_t)rowmap(mode, n0 + n) * K + k0 + 8 * c) = (unsigned long long)(unsigned)w0 | ((unsigned long long)(unsigned)w1 << 32); }
        else { v4u o; o.x = pk2(s[0 * 33], s[1 * 33]); o.y = pk2(s[2 * 33], s[3 * 33]); o.z = pk2(s[4 * 33], s[5 * 33]); o.w = pk2(s[6 * 33], s[7 * 33]);
        *(GAS v4u*)(WT + (size_t)rowmap(mode, n0 + n) * K + k0 + 8 * c) = o; } }
    LDS_WAIT(); asm volatile("" ::: "memory");
}

__device__ __forceinline__ void quant_rows(const bf16* X, unsigned char* X8, const float* ss, float* rsq, int w0, int nw, int lane) {
    for (int m0 = w0; m0 < M; m0 += 2 * nw) {
        v4u xw[2][2]; float sq[2];
#pragma unroll
        for (int u = 0; u < 2; ++u) { const int m = (m0 + u * nw) < M ? m0 + u * nw : m0;
            xw[u][0] = *(const GAS v4u*)(X + (size_t)m * DM + lane * 8); xw[u][1] = *(const GAS v4u*)(X + (size_t)m * DM + 512 + lane * 8);
            sq[u] = lane < 16 ? ss[(size_t)m * 16 + lane] : 0.f; }
#pragma unroll
        for (int u = 0; u < 2; ++u) { const int m = m0 + u * nw; if (m < M) {
            float x[16]; unpack8(xw[u][0], x); unpack8(xw[u][1], x + 8);
            float am = 0.f;
#pragma unroll
            for (int i = 0; i < 16; ++i) am = fmaxf(am, fabsf(x[i]));
#pragma unroll
            for (int o = 1; o < 64; o <<= 1) am = fmaxf(am, __shfl_xor(am, o));
            const float inv = am > 0.f ? 127.0f / am : 0.f;
            const unsigned long long q0 = (unsigned long long)pk4_i8(x[0] * inv, x[1] * inv, x[2] * inv, x[3] * inv) | ((unsigned long long)pk4_i8(x[4] * inv, x[5] * inv, x[6] * inv, x[7] * inv) << 32);
            const unsigned long long q1 = (unsigned long long)pk4_i8(x[8] * inv, x[9] * inv, x[10] * inv, x[11] * inv) | ((unsigned long long)pk4_i8(x[12] * inv, x[13] * inv, x[14] * inv, x[15] * inv) << 32);
            *(GAS unsigned long long*)(X8 + (size_t)m * DM + lane * 8) = q0; *(GAS unsigned long long*)(X8 + (size_t)m * DM + 512 + lane * 8) = q1;
            const float sqs = wave_sum(sq[u]);
            if (lane == 0) rsq[m] = (1.0f / sqrtf(sqs * (1.0f / 1024.0f) + EPS)) * (am * (1.0f / 127.0f)); } }
    }
}

__device__ __forceinline__ float ao_post(int l) { return 1.0f - (0.8f - 0.6f * expf(-0.3f * (float)l)); }
__device__ __forceinline__ float ao_rho(int l) { return AO_MLA_CLIP / (4.0f * ao_post(l)); }
__device__ __forceinline__ float ao_wq(int l) { return 127.0f * 32.0f / (4.0f * fmaxf(1.0f, ao_rho(l))); }
__device__ __forceinline__ void absorb_item(const float* Wukv, const float* Wo, bf16* WT, LAS float* scr, int item, int lane, float wq8 = 0.f) {
    const int ig = item & 3, nb = (item >> 2) & 31, jb = (item >> 7) & 1, h = item >> 8;
    const int j0 = 64 * jb + 16 * ig, n0 = 32 * nb, n = lane & 31, half = lane >> 5;
    float acc[8] = {0.f, 0.f, 0.f, 0.f, 0.f, 0.f, 0.f, 0.f};
    const float* ap = Wukv + (size_t)(j0 + half) * 1024 + h * 256 + 128;
    const float* bp = Wo + (size_t)(512 + 128 * h) * DM + n0 + n;
#pragma unroll 2
    for (int d4 = 0; d4 < 32; ++d4) {
        const float b0 = bp[(size_t)(4 * d4 + 0) * DM], b1 = bp[(size_t)(4 * d4 + 1) * DM], b2 = bp[(size_t)(4 * d4 + 2) * DM], b3 = bp[(size_t)(4 * d4 + 3) * DM];
#pragma unroll
        for (int i = 0; i < 8; ++i) { const f32x4 a4 = *(const GAS f32x4*)(ap + (size_t)(2 * i) * 1024 + 4 * d4); acc[i] += (a4.x * b0 + a4.y * b1) + (a4.z * b2 + a4.w * b3); }
    }
#pragma unroll
    for (int i = 0; i < 8; ++i) scr[(2 * i + half) * 33 + n] = acc[i];
    LDS_WAIT(); asm volatile("" ::: "memory");
    { const int n2 = lane >> 1, kh = lane & 1; const LAS float* sp = scr + (8 * kh) * 33 + n2;
      if (wq8 != 0.f) *(GAS unsigned long long*)((unsigned char*)WT + (size_t)(n0 + n2) * DM + 512 + 128 * h + j0 + 8 * kh) = (unsigned long long)pk4_i8(sp[0 * 33] * wq8, sp[1 * 33] * wq8, sp[2 * 33] * wq8, sp[3 * 33] * wq8) | ((unsigned long long)pk4_i8(sp[4 * 33] * wq8, sp[5 * 33] * wq8, sp[6 * 33] * wq8, sp[7 * 33] * wq8) << 32);
      else { v4u o; o.x = pk2(sp[0 * 33], sp[1 * 33]); o.y = pk2(sp[2 * 33], sp[3 * 33]); o.z = pk2(sp[4 * 33], sp[5 * 33]); o.w = pk2(sp[6 * 33], sp[7 * 33]);
      *(GAS v4u*)(WT + (size_t)(n0 + n2) * DM + 512 + 128 * h + j0 + 8 * kh) = o; } }
    LDS_WAIT(); asm volatile("" ::: "memory");
}

__global__ void __launch_bounds__(NWAVES * 64, 2) fwd_kernel(Args args) {
    extern __shared__ __attribute__((aligned(16))) unsigned char lds[];
    LAS unsigned char* ldsl = (LAS unsigned char*)lds;
    const int tid0 = threadIdx.x, wave = __builtin_amdgcn_readfirstlane(tid0 >> 6);
    const int G0 = gridDim.x; const int bx0 = blockIdx.x; const int vcu0 = (G0 % 8 == 0) ? (bx0 % 8) * (G0 / 8) + bx0 / 8 : bx0;
    unsigned char* ws0 = args.ws;
    gu32* ctl = (gu32*)(ws0 + WS_CTL);
    for (int u = tid0; u < (LDS_BYTES - LDSCTL_OFF) / 4; u += NWAVES * 64) ((LAS unsigned*)(ldsl + LDSCTL_OFF))[u] = 0u;
    __syncthreads();
    XcdBarrier bar; bar.bar = (unsigned*)(ctl + CW_BAR); bar.x = 0; bar.st = nullptr;
    if (!MK_PER_PHASE) bar = xcd_barrier_post((unsigned*)(ctl + CW_BAR), (volatile LAS unsigned*)(ldsl + MISC_OFF) + 8);
    const int lo = args.ph_lo, hi = args.ph_hi;
#define IN(k) (lo <= (k) && (k) < hi)
#define GRIDBAR() do { XcdBarrier b_ = bar; GAS unsigned* bb_ = (GAS unsigned*)b_.bar; asm volatile("" : "+s"(bb_)); b_.bar = (unsigned*)bb_; xcd_barrier(b_); if (DUP_BAR) xcd_barrier(b_); } while (0)
#define SEAM(k) do { if (!MK_PER_PHASE && IN(k) && IN((k) + 1)) GRIDBAR(); } while (0)
#define RFL(x) __builtin_amdgcn_readfirstlane(x)
#define gw (vcu * NWAVES + wave)
#define NGW (G * NWAVES)
#define PHASE_WS() GAS unsigned char* wsg_ = (GAS unsigned char*)ws0; asm volatile("" : "+s"(wsg_)); unsigned char* ws = (unsigned char*)wsg_; int G = G0, bx = bx0, vcu = vcu0; asm volatile("" : "+s"(G), "+s"(bx), "+s"(vcu)); (void)G; (void)bx; (void)vcu; int tid = tid0; asm volatile("" : "+v"(tid)); const int lane = tid & 63; (void)lane; auto ka_ = __builtin_amdgcn_kernarg_segment_ptr(); asm volatile("" : "+s"(ka_)); const GAS float* const __attribute__((address_space(4)))* INP = (const GAS float* const __attribute__((address_space(4)))*)ka_
#define SS ((float*)(ws + WS_SS))
#define ROPD ((float*)(ws + WS_ROPD))
#define ROPM ((float*)(ws + WS_ROPM))
#define MISCF ((float*)(ws + WS_MISC))
#define MISCI ((int*)(ws + WS_MISC))
#define XB ((bf16*)(ws + WS_XB))
#define AOB ((bf16*)(ws + WS_AO))
#define QM ((bf16*)(ws + WS_QM))
#define KVU ((bf16*)(ws + WS_KVU))
#define KM ((bf16*)(ws + WS_KM))
#define VM ((bf16*)(ws + WS_KVU))
#define KPR ((bf16*)(ws + WS_KVU + 32 * MiB))
#define KPESS ((float*)(ws + WS_KPESS))
#define CQN (l == 0 ? (bf16*)(ws + 457 * MiB) : (bf16*)((unsigned char*)outp + 64 * MiB))
#define CKVN (CQN + (size_t)M * MQR)
#define OD1 (l == 0 ? (float*)(ws + 393 * MiB) : outp)
#define WBL ((const bf16*)(ws + (l == 0 ? WS_W0 : WS_W1)))
#define PROJ (l == 0 ? (bf16*)outp : (bf16*)(ws + WS_PROJ1))
#define INPF(k) ((const float*)INP[k])
#define x_in INPF(0)
#define XG8 ((unsigned char*)outp + 32 * MiB)
#define XB8A ((unsigned char*)(ws + WS_AO))
#define XB8 ((unsigned char*)outp)
    float* outp = args.out;

    if (PH_ON(11) && IN(0)) for (int rep_ = 0; rep_ < REP(11); ++rep_) { PHASE_WS();
        LAS float* scr = (LAS float*)(ldsl + wave * 16384);
        constexpr int I_IN = 16 * 62, I_UQ = 4 * 24, I_UKV = 2 * 32, I_O = 16 * 32, I_AB = 4 * 2 * 32 * 4, I_L = I_IN + I_UQ + I_UKV + I_O + I_AB;
        constexpr int I_DG = 16 * 88, I_DD = 44 * 32, I_ME = 16 * 44, I_MD = 22 * 32;
        constexpr int NITEMS = 2 * I_L + 2 * I_DG + I_DD + 8 * (2 * I_ME + I_MD);
        for (int it = gw; it < NITEMS; it += NGW) {
            int r = it;
            if (r < 2 * I_L) { const int l = r / I_L; r -= l * I_L; bf16* wb = (bf16*)(ws + (l == 0 ? WS_W0 : WS_W1));
                if (r < I_IN) { tr_item(INPF(2) + (size_t)l * DM * INC, DM, INC, (bf16*)((char*)wb + WOFF_IN), INPF(1) + l * DM, 4, scr, r, lane, I8_IN ? 2 : 0); continue; } r -= I_IN;
                if (r < I_UQ) { tr_item(INPF(8) + (size_t)l * MQR * 768, MQR, 768, (bf16*)((char*)wb + WOFF_UQ), nullptr, 3, scr, r, lane, I8_UQ ? 2 : 0, WQ_UQ); continue; } r -= I_UQ;
                if (r < I_UKV) { if (((r & 31) & 7) < 4) tr_item(INPF(10) + (size_t)l * MKR * 1024, MKR, 1024, (bf16*)((char*)wb + WOFF_UKV), nullptr, 5, scr, r, lane); continue; } r -= I_UKV;
                if (r < I_AB) { absorb_item(INPF(10) + (size_t)l * MKR * 1024, INPF(12) + (size_t)l * DM * DM, (bf16*)((char*)wb + WOFF_O), scr, r, lane, I8_AO ? ao_wq(l) * ao_rho(l) : 0.f); continue; } r -= I_AB;
                if (r < 8 * 32) tr_item(INPF(12) + (size_t)l * DM * DM, DM, DM, (bf16*)((char*)wb + WOFF_O), nullptr, 0, scr, r, lane, I8_AO ? 2 : 0, ao_wq(l));
                continue; }
            r -= 2 * I_L;
            if (r < I_DG) { tr_item(INPF(14), DM, DFF, (bf16*)(ws + WS_W0 + WOFF_GU), INPF(13), 1, scr, r, lane, FP8_GU); continue; } r -= I_DG;
            if (r < I_DG) { tr_item(INPF(15), DM, DFF, (bf16*)(ws + WS_W0 + WOFF_GU), INPF(13), 2, scr, r, lane, FP8_GU); continue; } r -= I_DG;
            if (r < I_DD) { tr_item(INPF(16), DFF, DM, (bf16*)(ws + WS_W0 + WOFF_D), nullptr, 0, scr, r, lane, I8_DN ? 2 : 0, WQ_DN); continue; } r -= I_DD;
            if (r < 8 * I_ME) { const int e = r / I_ME; r -= e * I_ME; tr_item(INPF(18) + (size_t)e * DM * DFFE, DM, DFFE, I8_MOE ? (bf16*)(ws + WS_WMOE_GU + (size_t)e * 2816 * DM) : (bf16*)(ws + WS_WMOE_GU) + (size_t)e * 2816 * DM, INPF(13) + DM, 1, scr, r, lane, I8_MOE ? 2 : 0); continue; } r -= 8 * I_ME;
            if (r < 8 * I_ME) { const int e = r / I_ME; r -= e * I_ME; tr_item(INPF(19) + (size_t)e * DM * DFFE, DM, DFFE, I8_MOE ? (bf16*)(ws + WS_WMOE_GU + (size_t)e * 2816 * DM) : (bf16*)(ws + WS_WMOE_GU) + (size_t)e * 2816 * DM, INPF(13) + DM, 2, scr, r, lane, I8_MOE ? 2 : 0); continue; } r -= 8 * I_ME;
            { const int e = r / I_MD; r -= e * I_MD; if (I8_G2) tr_item(INPF(20) + (size_t)e * DFFE * DM, DFFE, DM, (bf16*)(ws + WS_WMOE_D + (size_t)e * DM * DFFP), nullptr, 0, scr, r, lane, 2, WQ_DM, DFFP);
              else tr_item(INPF(20) + (size_t)e * DFFE * DM, DFFE, DM, (bf16*)(ws + WS_WMOE_D) + (size_t)e * DM * DFFE, nullptr, 0, scr, r, lane); }
        }
        for (int i = gw * 64 + lane; i < 2 * 64 * 128; i += NGW * 64) { const int l = i / (64 * 128), rr = (i / 128) % 64, ch = i % 128;
            if (I8_IN) { if (ch < 64) *(GAS v4u*)(ws + (l == 0 ? WS_W0 : WS_W1) + WOFF_IN + (size_t)(INC + rr) * DM + ch * 16) = (v4u){0u, 0u, 0u, 0u}; }
            else *(GAS v4u*)((bf16*)(ws + (l == 0 ? WS_W0 : WS_W1) + WOFF_IN) + (size_t)(INC + rr) * DM + ch * 8) = (v4u){0u, 0u, 0u, 0u}; }
        if (I8_G2) for (int i = gw * 64 + lane; i < 8 * DM * 8; i += NGW * 64) { const int rowi = i >> 3, ch = i & 7;
            *(GAS v4u*)(ws + WS_WMOE_D + (size_t)rowi * DFFP + DFFE + ch * 16) = (v4u){0u, 0u, 0u, 0u}; }
        for (int i = gw * 64 + lane; i < 2 * 4 * 64 * 32; i += NGW * 64) { const int l = i / (4 * 64 * 32), h = (i / (64 * 32)) & 3, rr = (i / 32) & 63, ch = i & 31;
            if (I8_UQ) { if (ch < 16) *(GAS v4u*)(ws + (l == 0 ? WS_W0 : WS_W1) + WOFF_UQ + (size_t)(h * 256 + 192 + rr) * MQR + ch * 16) = (v4u){0u, 0u, 0u, 0u}; }
            else *(GAS v4u*)((bf16*)(ws + (l == 0 ? WS_W0 : WS_W1) + WOFF_UQ) + (size_t)(h * 256 + 192 + rr) * MQR + ch * 8) = (v4u){0u, 0u, 0u, 0u}; }
        for (int m = gw; m < M; m += NGW) {
            const GAS f32x4* xr = (const GAS f32x4*)(x_in + (size_t)m * DM) + lane; f32x4 v[4]; float s = 0.f;
#pragma unroll
            for (int j = 0; j < 4; ++j) { v[j] = __builtin_nontemporal_load(xr + 64 * j); s += (v[j].x * v[j].x + v[j].y * v[j].y) + (v[j].z * v[j].z + v[j].w * v[j].w); }
            s = wave_sum(s);
            GAS unsigned long long* o8 = (GAS unsigned long long*)(XB + (size_t)m * DM) + lane;
#pragma unroll
            for (int j = 0; j < 4; ++j) o8[64 * j] = (unsigned long long)pk2(v[j].x, v[j].y) | ((unsigned long long)pk2(v[j].z, v[j].w) << 32);
            if (lane < 16) SS[(size_t)m * 16 + lane] = lane == 0 ? s : 0.f;
            if (I8_IN) { float am = 0.f;
#pragma unroll
                for (int j = 0; j < 4; ++j) am = fmaxf(fmaxf(am, fmaxf(fabsf(v[j].x), fabsf(v[j].y))), fmaxf(fabsf(v[j].z), fabsf(v[j].w)));
#pragma unroll
                for (int o = 1; o < 64; o <<= 1) am = fmaxf(am, __shfl_xor(am, o));
                const float inv = am > 0.f ? 127.0f / am : 0.f;
                GAS unsigned* q8 = (GAS unsigned*)(XB8A + (size_t)m * DM) + lane;
#pragma unroll
                for (int j = 0; j < 4; ++j) q8[64 * j] = pk4_i8(v[j].x * inv, v[j].y * inv, v[j].z * inv, v[j].w * inv);
                if (lane == 0) { ((float*)(ws + WS_RS))[m] = (1.0f / sqrtf(s * (1.0f / 1024.0f) + EPS)) * (am * (1.0f / 127.0f));
                    ((float*)(ws + WS_RSC))[m] = am > 0.f ? am * (1.5f / 127.0f) : 1.0f; } }
        }
        for (int i = gw * 64 + lane; i < SEQ * 8; i += NGW * 64) { const int pos = i >> 3, k = i & 7;
            const float invf = 1.0f / powf(500000.0f, (float)k * (2.0f / 16.0f)); float s, c; sincos_rev((float)pos * invf, s, c);
            ROPD[pos * 16 + k] = c; ROPD[pos * 16 + 8 + k] = s; }
        for (int i = gw * 64 + lane; i < SEQ * 32; i += NGW * 64) { const int pos = i >> 5, k = i & 31;
            const float invf = 1.0f / powf(10000.0f, (float)k * (2.0f / 64.0f)); float s, c; sincos_rev((float)pos * invf, s, c);
            ROPM[pos * 64 + k] = c; ROPM[pos * 64 + 32 + k] = s; }
        for (int i = gw * 64 + lane; i < DM * NEXP; i += NGW * 64) ((float*)(ws + WS_RW))[i] = INPF(17)[i] * INPF(13)[DM + (i >> 3)];
        for (int i = gw * 64 + lane; i < DEPTH * GT_L; i += NGW * 64) { const int l = i / GT_L, j = i % GT_L; float v;
            if (j < 64) v = INPF(3)[l * 64 + j]; else if (j < 128) v = INPF(4)[l * 64 + j - 64]; else if (j < 384) v = INPF(7)[l * 256 + j - 128]; else if (j < 512) v = INPF(9)[l * 128 + j - 384];
            else if (j < 896) v = INPF(11)[l * 384 + j - 512]; else v = INPF(6)[l * 128 + j - 896];
            MISCF[MI_GT + i] = v; }
        if (gw < DEPTH) { const int l = gw;
            const float* lp = INPF(5) + l * 256; const float a = wave_sum(lp[lane] * lp[64 + lane]), b = wave_sum(lp[128 + lane] * lp[192 + lane]);
            const float lam_init = 0.8f - 0.6f * expf(-0.3f * (float)l);
            float gq = fabsf(INPF(3)[l * 64 + lane]), gk = fabsf(INPF(4)[l * 64 + lane]);
            float mq = fmaxf(fmaxf(fabsf(INPF(11)[l * 384 + lane]), fabsf(INPF(11)[l * 384 + 64 + lane])), fabsf(INPF(11)[l * 384 + 128 + lane]));
            float mk = fmaxf(fmaxf(fabsf(INPF(11)[l * 384 + 192 + lane]), fabsf(INPF(11)[l * 384 + 256 + lane])), fabsf(INPF(11)[l * 384 + 320 + lane]));
#pragma unroll
            for (int o = 1; o < 64; o <<= 1) { gq = fmaxf(gq, __shfl_xor(gq, o)); gk = fmaxf(gk, __shfl_xor(gk, o)); mq = fmaxf(mq, __shfl_xor(mq, o)); mk = fmaxf(mk, __shfl_xor(mk, o)); }
            if (lane == 0) { MISCF[MI_LAM + l] = expf(a) - expf(b) + lam_init;
                MISCF[MI_BIASD + l] = -(0.125f * LOG2E * 64.0f * gq * gk * 1.02f); MISCF[MI_BIASM + l] = -(0.07216878364870322f * LOG2E * 192.0f * mq * mk * 1.02f); }
        }
    }
    SEAM(0);

#define SEAM2(a, b) do { if (!MK_PER_PHASE && IN(a) && IN(b)) GRIDBAR(); } while (0)
#pragma unroll 1
    for (int l = 0; l < DEPTH; ++l) {
        const int P = 1 + 10 * l;
        if (PH_ON(0) && IN(P + 0)) for (int rep_ = 0; rep_ < REP(0); ++rep_) { PHASE_WS();
#if I8_IN
            pg8::Gemm g{(const bf16*)(l == 0 ? XB8A : XB8), (const bf16*)((const char*)WBL + WOFF_IN), DM / 2, DM / 2}; pg8::StaticOrder S; S.init(M, INCP, G, bx);
            pg8::EpiInProj E{PROJ, ws, MISCF + MI_GT + l * GT_L, (LAS float*)(ldsl + PART_OFF), (const float*)(ws + WS_RS), (LAS float*)(ldsl + PART_OFF + 8192), CQN};
            pg8::gemm_phase<pg8::EpiInProj, pg8::StaticOrder, true, 2>(ldsl, g, S, E);
#else
            pg8::Gemm g{XB, (const bf16*)((const char*)WBL + WOFF_IN), DM, DM}; pg8::StaticOrder S; S.init(M, INCP, G, bx);
            pg8::EpiInProj E{PROJ, ws, MISCF + MI_GT + l * GT_L, (LAS float*)(ldsl + PART_OFF), SS, (LAS float*)(ldsl + PART_OFF + 8192), CQN};
            pg8::gemm_phase<pg8::EpiInProj, pg8::StaticOrder>(ldsl, g, S, E);
#endif
        }
        SEAM2(P + 0, P + 2);
        if (false && PH_ON(1) && IN(P + 1)) { PHASE_WS();
            const float* gq = INPF(3) + l * 64; const float* gk = INPF(4) + l * 64; const float* gqln = INPF(7) + l * MQR; const float* gkvln = INPF(9) + l * MKR;
            const int d8 = (lane & 7) * 8, sub = lane & 7;
            float gqv[8], gkv[8];
#pragma unroll
            for (int i = 0; i < 8; ++i) { gqv[i] = gq[d8 + i] * (0.125f * LOG2E); gkv[i] = gk[d8 + i]; }
            for (int m = gw; m < M; m += NGW) {
                bf16* row = PROJ + (size_t)m * INCP; const int pos = m & (SEQ - 1);
                const v4u wq = *(const GAS v4u*)(row + lane * 8), wk = *(const GAS v4u*)(row + 512 + lane * 8), wcv = *(const GAS v4u*)(row + 1536 + lane * 8);
                float cs[8], sn[8];
                { const f32x4 c0 = *(const GAS f32x4*)(ROPD + pos * 16), c1 = *(const GAS f32x4*)(ROPD + pos * 16 + 4), s0 = *(const GAS f32x4*)(ROPD + pos * 16 + 8), s1 = *(const GAS f32x4*)(ROPD + pos * 16 + 12);
#pragma unroll
                  for (int i = 0; i < 4; ++i) { cs[i] = c0[i]; cs[4 + i] = c1[i]; sn[i] = s0[i]; sn[4 + i] = s1[i]; } }
#pragma unroll
                for (int which = 0; which < 2; ++which) {
                    float v[8]; unpack8(which == 0 ? wq : wk, v); float s = 0.f;
#pragma unroll
                    for (int i = 0; i < 8; ++i) s += v[i] * v[i];
                    s += __shfl_xor(s, 1); s += __shfl_xor(s, 2); s += __shfl_xor(s, 4);
                    const float rinv = 1.0f / sqrtf(s * (1.0f / 64.0f) + EPS);
#pragma unroll
                    for (int i = 0; i < 8; ++i) v[i] *= rinv * (which == 0 ? gqv[i] : gkv[i]);
#pragma unroll
                    for (int i = 0; i < 8; ++i) { const float other = __shfl_xor(v[i], 1);
                        if (sub == 0) v[i] = v[i] * cs[i] - other * sn[i]; else if (sub == 1) v[i] = v[i] * cs[i] + other * sn[i]; }
                    *(GAS v4u*)(row + which * 512 + lane * 8) = pack8v(v);
                }
                { float v[8]; unpack8(wcv, v); float s = 0.f;
#pragma unroll
                  for (int i = 0; i < 8; ++i) s += v[i] * v[i];
                  s += __shfl_xor(s, 1); s += __shfl_xor(s, 2); s += __shfl_xor(s, 4); s += __shfl_xor(s, 8); const float s16 = s; const float s32 = s + __shfl_xor(s, 16);
                  if (lane < 32) { const float rinv = 1.0f / sqrtf(s32 * (1.0f / 256.0f) + EPS);
#pragma unroll
                      for (int i = 0; i < 8; ++i) v[i] *= rinv * gqln[lane * 8 + i];
                      *(GAS v4u*)(CQN + (size_t)m * MQR + lane * 8) = pack8v(v); }
                  else if (lane < 48) { const float rinv = 1.0f / sqrtf(s16 * (1.0f / 128.0f) + EPS);
#pragma unroll
                      for (int i = 0; i < 8; ++i) v[i] *= rinv * gkvln[(lane - 32) * 8 + i];
                      *(GAS v4u*)(CKVN + (size_t)m * MKR + (lane - 32) * 8) = pack8v(v); } }
            }
        }
        if (PH_ON(2) && IN(P + 2)) for (int rep_ = 0; rep_ < REP(2); ++rep_) { PHASE_WS();
            { pg8::Gemm g{CKVN, (const bf16*)((const char*)WBL + WOFF_UKV), MKR, MKR}; pg8::StaticOrder S; S.init(M, 512, G, bx);
              pg8::EpiMlaKV E{KM, KPR, KPESS, INPF(11) + l * 384 + 192, (LAS float*)(ldsl + PART_OFF)};
              pg8::gemm_phase<pg8::EpiMlaKV, pg8::StaticOrder>(ldsl, g, S, E); }
#if I8_UQ
            { pg8::Gemm g{CQN, (const bf16*)((const char*)WBL + WOFF_UQ), MQR / 2, MQR / 2}; pg8::StaticOrder S; S.init(M, 1024, G, bx);
              pg8::EpiMlaQ E{QM, ROPM, INPF(11) + l * 384, (LAS float*)(ldsl + PART_OFF), CQ_STEP / WQ_UQ};
              pg8::gemm_phase<pg8::EpiMlaQ, pg8::StaticOrder, true, 2>(ldsl, g, S, E); }
#else
            { pg8::Gemm g{CQN, (const bf16*)((const char*)WBL + WOFF_UQ), MQR, MQR}; pg8::StaticOrder S; S.init(M, 1024, G, bx);
              pg8::EpiMlaQ E{QM, ROPM, INPF(11) + l * 384, (LAS float*)(ldsl + PART_OFF), 1.0f};
              pg8::gemm_phase<pg8::EpiMlaQ, pg8::StaticOrder>(ldsl, g, S, E); }
#endif
        }
        SEAM2(P + 2, P + 4);
        if (false && PH_ON(3) && IN(P + 3)) { PHASE_WS();
            const float* gq = INPF(11) + l * 384; const float* gk = gq + 192;
            const int li = lane & 31, lic = li < 24 ? li : 0; const bool act = li < 24;
            float gqv[8], gkv[8];
#pragma unroll
            for (int i = 0; i < 8; ++i) { gqv[i] = gq[lic * 8 + i] * (0.07216878364870322f * LOG2E); gkv[i] = gk[lic * 8 + i]; }
            const int jb = (li & 3) * 8; const int partner = (li < 20) ? lane + 4 : lane - 4; const bool isx1 = (li >= 16 && li < 20), isx2 = (li >= 20 && li < 24);
            for (int m = gw; m < M; m += NGW) {
                const int pos = m & (SEQ - 1);
                float cs[8], sn[8];
                { const float* rp = ROPM + pos * 64 + jb; const f32x4 c0 = *(const GAS f32x4*)(rp), c1 = *(const GAS f32x4*)(rp + 4), s0 = *(const GAS f32x4*)(rp + 32), s1 = *(const GAS f32x4*)(rp + 36);
#pragma unroll
                  for (int i = 0; i < 4; ++i) { cs[i] = c0[i]; cs[4 + i] = c1[i]; sn[i] = s0[i]; sn[4 + i] = s1[i]; } }
#pragma unroll
                for (int it = 0; it < 2; ++it) {
                    const int h = 2 * it + (lane >> 5);
#pragma unroll
                    for (int which = 0; which < 2; ++which) {
                        v4u w = (v4u){0u, 0u, 0u, 0u};
                        if (act) { if (which == 0) w = *(const GAS v4u*)(QM + (size_t)m * 768 + h * 192 + li * 8);
                                   else w = (li < 16) ? *(const GAS v4u*)(KVU + (size_t)m * 1024 + h * 256 + li * 8) : *(const GAS v4u*)(PROJ + (size_t)m * INCP + 1920 + (li - 16) * 8); }
                        float v[8]; unpack8(w, v); float s = 0.f;
#pragma unroll
                        for (int i = 0; i < 8; ++i) s += v[i] * v[i];
                        s += __shfl_xor(s, 1); s += __shfl_xor(s, 2); s += __shfl_xor(s, 4); s += __shfl_xor(s, 8); s += __shfl_xor(s, 16);
                        const float rinv = 1.0f / sqrtf(s * (1.0f / 192.0f) + EPS);
#pragma unroll
                        for (int i = 0; i < 8; ++i) v[i] *= rinv * (which == 0 ? gqv[i] : gkv[i]);
#pragma unroll
                        for (int i = 0; i < 8; ++i) { const float other = __shfl(v[i], partner);
                            if (isx1) v[i] = v[i] * cs[i] - other * sn[i]; else if (isx2) v[i] = v[i] * cs[i] + other * sn[i]; }
                        if (act) { bf16* dst = (which == 0 ? QM : KM) + (size_t)m * 768 + h * 192 + li * 8; *(GAS v4u*)dst = pack8v(v); }
                    }
                }
            }
        }
        if (PH_ON(4) && IN(P + 4)) for (int rep_ = 0; rep_ < REP(4); ++rep_) { PHASE_WS();
            const float lam = MISCF[MI_LAM + l], lam_init = 0.8f - 0.6f * expf(-0.3f * (float)l);
            for (int p = vcu; p < 256; p += G) {
                const int b = p >> 5, h = (p >> 3) & 3, s = p & 7;
                const size_t r0 = (size_t)b * SEQ;
#pragma unroll 1
                for (int pass = 0; pass < 2; ++pass) {
                    const int qb = pass == 0 ? 15 - s : s;
                    att::AttnOut A1{nullptr, OD1 + (size_t)((b * 4 + h) * 16 + qb) * 16384, 0, 512, 0.f, 0.f, nullptr, 0.f};
                    if (ATT_SEL & 1) att::attn_unit<64, 1, INCP, INCP, INCP, true>(PROJ + r0 * INCP + h * 128, PROJ + r0 * INCP + 512 + h * 128, PROJ + r0 * INCP + 1024 + h * 128, qb, A1, (char*)lds, ldsl);
                    att::AttnOut A2{I8_AO ? (bf16*)((unsigned char*)AOB + r0 * DM + h * 128) : AOB + r0 * DM + h * 128, OD1 + (size_t)((b * 4 + h) * 16 + qb) * 16384, DM, 512, lam, 1.0f - lam_init, INPF(6) + l * 128, I8_AO ? 127.0f / (4.0f * (1.0f - lam_init)) : 0.f};
                    if (ATT_SEL & 2) att::attn_unit<64, 2, INCP, INCP, INCP, true>(PROJ + r0 * INCP + h * 128 + 64, PROJ + r0 * INCP + 512 + h * 128 + 64, PROJ + r0 * INCP + 1024 + h * 128, qb, A2, (char*)lds, ldsl);
                }
#pragma unroll 1
                for (int pass = 0; pass < 2; ++pass) {
                    const int qb = pass == 0 ? 15 - s : s;
                    att::AttnOut A0{I8_AO ? (bf16*)((unsigned char*)AOB + r0 * DM + 512 + h * 128) : AOB + r0 * DM + 512 + h * 128, nullptr, DM, 0, 0.f, 0.f, nullptr, I8_AO ? 127.0f / AO_MLA_CLIP : 0.f};
                    if (ATT_SEL & 4) att::attn_unit<192, 0, 768, 768, MKR, false>(QM + r0 * 768 + h * 192, KM + r0 * 768 + h * 192, CKVN + r0 * MKR, qb, A0, (char*)lds, ldsl);
                }
            }
        }
        SEAM(P + 4);
        if (PH_ON(5) && IN(P + 5)) { PHASE_WS();
#if I8_AO
            pg8::Gemm g{AOB, (const bf16*)((const char*)WBL + WOFF_O), DM / 2, DM / 2}; pg8::StaticOrder S; S.init(M, DM, G, bx);
#else
            pg8::Gemm g{AOB, (const bf16*)((const char*)WBL + WOFF_O), DM, DM}; pg8::StaticOrder S; S.init(M, DM, G, bx);
#endif
            pg8::EpiResid E{XB, SS, ((FP8_GU == 1 || (FP8_GU == 2 && QPRED)) && l == 0) ? XB8 : nullptr, I8_AO ? (4.0f * ao_post(l) / 127.0f) / ao_wq(l) : 1.0f, (FP8_GU == 2 && QPRED && l == 0) ? (const float*)(ws + WS_RSC) : nullptr};
            pg8::gemm_phase<pg8::EpiResid, pg8::StaticOrder, true, I8_AO ? 2 : 0>(ldsl, g, S, E);
        }
        SEAM(P + 5);
        if (l == 0) {
#define ACT0 ((bf16*)(ws + WS_ACT0))
#if FP8_GU == 2 && !QPRED
            if (PH_ON(6) && IN(P + 6)) { PHASE_WS();
                quant_rows(XB, XB8, SS, (float*)(ws + WS_RS), gw, NGW, lane);
            }
            if (!MK_PER_PHASE && IN(P + 6)) GRIDBAR();
#endif
            if (PH_ON(6) && IN(P + 6)) for (int rep_ = 0; rep_ < REP(6); ++rep_) { PHASE_WS();
#if FP8_GU == 2
                pg8::Gemm g{(const bf16*)XB8, (const bf16*)(ws + WS_W0 + WOFF_GU), DM / 2, DM / 2}; pg8::StaticOrder S; S.init(M, 2 * DFF, G, bx);
                pg8::EpiSwiGLU E{ACT0, DFF, QPRED ? (const float*)SS : (const float*)(ws + WS_RS), QPRED ? 0 : 1, (LAS float*)(ldsl + PART_OFF + 8192), 1.0f / WQ_I8, I8_DN, QPRED ? (const float*)(ws + WS_RSC) : nullptr};
                pg8::gemm_phase<pg8::EpiSwiGLU, pg8::StaticOrder, true, 2>(ldsl, g, S, E);
#elif FP8_GU == 1
                pg8::Gemm g{(const bf16*)XB8, (const bf16*)(ws + WS_W0 + WOFF_GU), DM / 2, DM / 2}; pg8::StaticOrder S; S.init(M, 2 * DFF, G, bx);
                pg8::EpiSwiGLU E{ACT0, DFF, SS, 0, (LAS float*)(ldsl + PART_OFF + 8192), 1.0f / 64.0f, 0, nullptr};
                pg8::gemm_phase<pg8::EpiSwiGLU, pg8::StaticOrder, true, 1>(ldsl, g, S, E);
#else
                pg8::Gemm g{XB, (const bf16*)(ws + WS_W0 + WOFF_GU), DM, DM}; pg8::StaticOrder S; S.init(M, 2 * DFF, G, bx);
                pg8::EpiSwiGLU E{ACT0, DFF, SS, 0, (LAS float*)(ldsl + PART_OFF + 8192), 1.0f, 0, nullptr};
                pg8::gemm_phase<pg8::EpiSwiGLU, pg8::StaticOrder>(ldsl, g, S, E);
#endif
                if (PROBE_NULL_GU == 1) { pg8::EpiNull EN{(float*)(ws + WS_RS)}; pg8::gemm_phase<pg8::EpiNull, pg8::StaticOrder>(ldsl, g, S, EN); }
                if (PROBE_NULL_GU == 2) { pg8::EpiProbe<2> EN{(bf16*)(ws + 393 * MiB), DFF, SS, (float*)(ws + WS_RS)}; pg8::gemm_phase<pg8::EpiProbe<2>, pg8::StaticOrder>(ldsl, g, S, EN); }
                if (PROBE_NULL_GU == 3) { pg8::EpiProbe<3> EN{(bf16*)(ws + 393 * MiB), DFF, SS, (float*)(ws + WS_RS)}; pg8::gemm_phase<pg8::EpiProbe<3>, pg8::StaticOrder>(ldsl, g, S, EN); }
            }
            SEAM(P + 6);
            if (PH_ON(7) && IN(P + 7)) { PHASE_WS();
#if I8_DN
                pg8::Gemm g{ACT0, (const bf16*)(ws + WS_W0 + WOFF_D), DFF / 2, DFF / 2}; pg8::StaticOrder S; S.init(M, DM, G, bx);
                pg8::EpiResid E{XB, SS, nullptr, (ACT_CLIP / 127.0f) / WQ_DN, nullptr};
                pg8::gemm_phase<pg8::EpiResid, pg8::StaticOrder, true, 2>(ldsl, g, S, E);
#else
                pg8::Gemm g{ACT0, (const bf16*)(ws + WS_W0 + WOFF_D), DFF, DFF}; pg8::StaticOrder S; S.init(M, DM, G, bx);
                pg8::EpiResid E{XB, SS, nullptr, 1.0f, nullptr};
                pg8::gemm_phase<pg8::EpiResid, pg8::StaticOrder>(ldsl, g, S, E);
#endif
            }
            SEAM2(P + 7, P + 10);
#if I8_IN
            if (PH_ON(7) && IN(P + 7)) { PHASE_WS();
                quant_rows(XB, XB8, SS, (float*)(ws + WS_RS), gw, NGW, lane);
            }
            if (!MK_PER_PHASE && IN(P + 7)) GRIDBAR();
#endif
        } else {
#define TOKE ((int*)(ws + WS_TOKE))
#define TOKG ((float*)(ws + WS_TOKG))
#define RSC ((float*)(ws + WS_RSC))
#define SLOT ((int*)(ws + WS_SLOT))
#define RS ((float*)(ws + WS_RS))
#define CNT ((int*)(ws + WS_CNT))
#define XG ((bf16*)(ws + WS_XG))
#define ACTG ((bf16*)(ws + WS_ACTG))
#define Y2 ((bf16*)(ws + 480 * MiB))
#define RPW (M / G)
            if (PH_ON(6) && IN(P + 6)) for (int rep_ = 0; rep_ < REP(6); ++rep_) { PHASE_WS();
                LAS float* RWt = (LAS float*)ldsl;
                LAS int* cnt = (LAS int*)(ldsl + 32768);
                for (int i = tid; i < DM * NEXP; i += NWAVES * 64) { const int k = i >> 3, e = i & 7; RWt[e * DM + k] = INPF(17)[i] * INPF(13)[DM + k]; }
                if (tid < 8) cnt[tid] = 0;
                __syncthreads();
                const int rpw = RPW / NWAVES;
                for (int i = 0; i < rpw; ++i) {
                    const int m = vcu * RPW + wave * rpw + i;
                    float lg[8] = {0.f, 0.f, 0.f, 0.f, 0.f, 0.f, 0.f, 0.f}; float ssq = 0.f, am = 0.f;
                    v4u xw[2];
#pragma unroll
                    for (int j = 0; j < 2; ++j) xw[j] = *(const GAS v4u*)(XB + (size_t)m * DM + lane * 8 + 512 * j);
#pragma unroll
                    for (int j = 0; j < 2; ++j) { float xv[8]; unpack8(xw[j], xv);
                        if (I8_MOE) {
#pragma unroll
                            for (int e = 0; e < 8; ++e) am = fmaxf(am, fabsf(xv[e])); }
                        ssq += ((xv[0] * xv[0] + xv[1] * xv[1]) + (xv[2] * xv[2] + xv[3] * xv[3])) + ((xv[4] * xv[4] + xv[5] * xv[5]) + (xv[6] * xv[6] + xv[7] * xv[7]));
#pragma unroll
                        for (int e = 0; e < 8; ++e) { const f32x4 wa = *(const LAS f32x4*)(RWt + e * DM + lane * 8 + 512 * j), wb = *(const LAS f32x4*)(RWt + e * DM + lane * 8 + 512 * j + 4);
                            lg[e] += ((xv[0] * wa[0] + xv[1] * wa[1]) + (xv[2] * wa[2] + xv[3] * wa[3])) + ((xv[4] * wb[0] + xv[5] * wb[1]) + (xv[6] * wb[2] + xv[7] * wb[3])); } }
                    ssq = wave_sum(ssq);
#pragma unroll
                    for (int e = 0; e < 8; ++e) lg[e] = wave_sum(lg[e]);
                    const float r = 1.0f / sqrtf(ssq * (1.0f / 1024.0f) + EPS);
                    float qsc = 1.0f;
                    if (I8_MOE) {
#pragma unroll
                        for (int o = 1; o < 64; o <<= 1) am = fmaxf(am, __shfl_xor(am, o));
                        const float inv = am > 0.f ? 127.0f / am : 0.f; qsc = am * (1.0f / 127.0f);
#pragma unroll
                        for (int j = 0; j < 2; ++j) { float xv[8]; unpack8(xw[j], xv);
                            const unsigned long long q = (unsigned long long)pk4_i8(xv[0] * inv, xv[1] * inv, xv[2] * inv, xv[3] * inv) | ((unsigned long long)pk4_i8(xv[4] * inv, xv[5] * inv, xv[6] * inv, xv[7] * inv) << 32);
                            *(GAS unsigned long long*)(XB8 + (size_t)m * DM + lane * 8 + 512 * j) = q; } }
                    int e0 = 0; float l0 = lg[0];
#pragma unroll
                    for (int e = 1; e < 8; ++e) if (lg[e] > l0) { l0 = lg[e]; e0 = e; }
                    int e1 = -1; float l1 = -__builtin_inff();
#pragma unroll
                    for (int e = 0; e < 8; ++e) if (e != e0 && lg[e] > l1) { l1 = lg[e]; e1 = e; }
                    const float g0 = 1.0f / (1.0f + expf((l1 - l0) * r)), g1 = 1.0f - g0;
                    if (lane == 0) { TOKE[m] = e0 | (e1 << 8); TOKG[2 * m] = g0; TOKG[2 * m + 1] = g1; RSC[m] = r * qsc;
                        __hip_atomic_fetch_add(cnt + e0, 1, __ATOMIC_RELAXED, __HIP_MEMORY_SCOPE_WORKGROUP); __hip_atomic_fetch_add(cnt + e1, 1, __ATOMIC_RELAXED, __HIP_MEMORY_SCOPE_WORKGROUP); }
                }
                __syncthreads();
                if (tid < 8) CNT[vcu * 8 + tid] = cnt[tid];
                __syncthreads();
            }
            SEAM(P + 6);
            if (PH_ON(7) && IN(P + 7)) { PHASE_WS();
                LAS int* tot = (LAS int*)ldsl; LAS int* pre = tot + 8; LAS int* slots_l = tot + 16;
                { int c = 0, cp = 0;
                  for (int j = 0; j < (G + 63) / 64; ++j) { const int idx = lane + 64 * j; if (idx < G) { const int v = CNT[idx * 8 + wave]; c += v; if (idx < vcu) cp += v; } }
#pragma unroll
                  for (int o = 1; o < 64; o <<= 1) { c += __shfl_xor(c, o); cp += __shfl_xor(cp, o); }
                  if (lane == 0) { tot[wave] = c; pre[wave] = cp; } }
                __syncthreads();
                int ce[9]; ce[0] = 0;
#pragma unroll
                for (int e = 0; e < 8; ++e) ce[e + 1] = ce[e] + (tot[e] + 255) / 256;
                if (vcu == 0 && tid == 0) {
#pragma unroll
                    for (int e = 0; e < 9; ++e) MISCI[MI_MOEC + e] = ce[e]; }
                if (wave == 0) {
                    int cur[8];
#pragma unroll
                    for (int e = 0; e < 8; ++e) cur[e] = 256 * ce[e] + pre[e];
                    const unsigned long long lt = (1ull << lane) - 1ull;
                    for (int ch = 0; ch < RPW / 64; ++ch) {
                        const int tl = ch * 64 + lane, tok = vcu * RPW + tl; const int ee = TOKE[tok]; const int e0 = ee & 255, e1 = ee >> 8; int s0 = 0, s1 = 0;
#pragma unroll
                        for (int e = 0; e < 8; ++e) { const unsigned long long m0 = __ballot(e0 == e), m1 = __ballot(e1 == e);
                            if (e0 == e) s0 = cur[e] + __popcll(m0 & lt);
                            if (e1 == e) s1 = cur[e] + __popcll(m0) + __popcll(m1 & lt);
                            cur[e] += __popcll(m0) + __popcll(m1); }
                        SLOT[2 * tok] = s0; SLOT[2 * tok + 1] = s1; slots_l[2 * tl] = s0; slots_l[2 * tl + 1] = s1;
                    }
                }
                __syncthreads();
                const int per = (2 * RPW) / NWAVES;
                for (int i = 0; i < per; ++i) { const int idx = wave * per + i, tl = idx >> 1, tok = vcu * RPW + tl; const int slot = slots_l[idx];
                    if (I8_MOE) { const v4u a = *(const GAS v4u*)(XB8 + (size_t)tok * DM + lane * 16); *(GAS v4u*)(XG8 + (size_t)slot * DM + lane * 16) = a; }
                    else { const v4u a = *(const GAS v4u*)(XB + (size_t)tok * DM + lane * 8), b2 = *(const GAS v4u*)(XB + (size_t)tok * DM + 512 + lane * 8);
                    *(GAS v4u*)(XG + (size_t)slot * DM + lane * 8) = a; *(GAS v4u*)(XG + (size_t)slot * DM + 512 + lane * 8) = b2; }
                    if (lane == 0) RS[slot] = RSC[tok]; }
                if (vcu < 8) {
                    int c0 = 0, c1 = 0, te = 0;
#pragma unroll
                    for (int e = 0; e < 8; ++e) if (e == vcu) { c0 = ce[e]; c1 = ce[e + 1]; te = tot[e]; }
                    for (int rrow = 256 * c0 + te + wave; rrow < 256 * c1; rrow += NWAVES) {
                        unsigned zz = 0u; asm volatile("" : "+v"(zz)); const v4u z4 = (v4u){zz, zz, zz, zz};
                        if (I8_MOE) *(GAS v4u*)(XG8 + (size_t)rrow * DM + lane * 16) = z4;
                        else { *(GAS v4u*)(XG + (size_t)rrow * DM + lane * 8) = z4; *(GAS v4u*)(XG + (size_t)rrow * DM + 512 + lane * 8) = z4; }
                        if (lane == 0) RS[rrow] = 0.f; }
                }
                __syncthreads();
            }
            SEAM(P + 7);
#define MOE_C RFL(MISCI[MI_MOEC + 1]), RFL(MISCI[MI_MOEC + 2]), RFL(MISCI[MI_MOEC + 3]), RFL(MISCI[MI_MOEC + 4]), RFL(MISCI[MI_MOEC + 5]), RFL(MISCI[MI_MOEC + 6]), RFL(MISCI[MI_MOEC + 7])
            if (PH_ON(8) && IN(P + 8)) { PHASE_WS();
                const int nrt = RFL(MISCI[MI_MOEC + 8]), nfull = nrt < 256 ? nrt : 256;
                pg8::MoeOrder S{MOE_C, 0, nfull, 11, G, vcu};
#if I8_MOE
                pg8::Gemm g{(const bf16*)XG8, (const bf16*)(ws + WS_WMOE_GU), DM / 2, DM / 2};
                pg8::EpiSwiGLU E{ACTG, I8_G2 ? DFFP : DFFE, RS, 1, (LAS float*)(ldsl + PART_OFF + 8192), 1.0f / WQ_I8, I8_G2, nullptr};
                pg8::gemm_phase<pg8::EpiSwiGLU, pg8::MoeOrder, true, 2>(ldsl, g, S, E);
#else
                pg8::Gemm g{XG, (const bf16*)(ws + WS_WMOE_GU), DM, DM};
                pg8::EpiSwiGLU E{ACTG, DFFE, RS, 1, (LAS float*)(ldsl + PART_OFF + 8192), 1.0f, 0, nullptr};
                pg8::gemm_phase<pg8::EpiSwiGLU, pg8::MoeOrder>(ldsl, g, S, E);
#endif
            }
            SEAM(P + 8);
            if (PH_ON(9) && IN(P + 9)) {
                { PHASE_WS();
                  const int nrt = RFL(MISCI[MI_MOEC + 8]), nfull = nrt < 256 ? nrt : 256;
                  if (bx < (nrt - nfull) * 11) {
                      pg8::MoeOrder S{MOE_C, nfull, nrt, 11, G, bx};
#if I8_MOE
                      pg8::Gemm g{(const bf16*)XG8, (const bf16*)(ws + WS_WMOE_GU), DM / 2, DM / 2};
                      pg8::EpiSwiGLU E{ACTG, I8_G2 ? DFFP : DFFE, RS, 1, (LAS float*)(ldsl + PART_OFF + 8192), 1.0f / WQ_I8, I8_G2, nullptr};
                      pg8::gemm_phase<pg8::EpiSwiGLU, pg8::MoeOrder, true, 2>(ldsl, g, S, E);
#else
                      pg8::Gemm g{XG, (const bf16*)(ws + WS_WMOE_GU), DM, DM};
                      pg8::EpiSwiGLU E{ACTG, DFFE, RS, 1, (LAS float*)(ldsl + PART_OFF + 8192), 1.0f, 0, nullptr};
                      pg8::gemm_phase<pg8::EpiSwiGLU, pg8::MoeOrder>(ldsl, g, S, E);
#endif
                      int mine = 0; for (int L = bx; L < (nrt - nfull) * 11; L += G) ++mine;
                      asm volatile("s_waitcnt vmcnt(0)" ::: "memory");
                      __syncthreads();
                      if (tid == 0) { __builtin_amdgcn_fence(__ATOMIC_RELEASE, "agent"); asm volatile("s_waitcnt vmcnt(0)" ::: "memory");
                          __hip_atomic_fetch_add((unsigned*)(ws + WS_CTL) + CW_TAIL, (unsigned)mine, __ATOMIC_RELAXED, __HIP_MEMORY_SCOPE_AGENT); }
                      __syncthreads();
                  } }
                { PHASE_WS();
                  const int nrt = RFL(MISCI[MI_MOEC + 8]), nfull = nrt < 256 ? nrt : 256, nb = (nrt - nfull) * 11;
                  const int rs = nfull - (nb + 3) / 4, rank = bx >= nb ? bx - nb : G - nb + bx;
                  pg8::MoeOrder S{MOE_C, 0, rs, 4, G, rank};
#if I8_G2
                  pg8::Gemm g{ACTG, (const bf16*)(ws + WS_WMOE_D), DFFP / 2, DFFP / 2};
                  pg8::EpiScaleBf16 E{XG, DM, nullptr, (ACT_CLIP / 127.0f) / WQ_DM};
                  pg8::gemm_phase<pg8::EpiScaleBf16, pg8::MoeOrder, true, 2>(ldsl, g, S, E); }
#else
                  pg8::Gemm g{ACTG, (const bf16*)(ws + WS_WMOE_D), DFFE, DFFE};
                  pg8::EpiScaleBf16 E{XG, DM, nullptr, 1.0f};
                  pg8::gemm_phase<pg8::EpiScaleBf16, pg8::MoeOrder>(ldsl, g, S, E); }
#endif
                { PHASE_WS();
                  const int nrt = RFL(MISCI[MI_MOEC + 8]), nfull = nrt < 256 ? nrt : 256, nb = (nrt - nfull) * 11;
                  const int rs = nfull - (nb + 3) / 4, rank = bx >= nb ? bx - nb : G - nb + bx;
                  const int F = 4 * rs, nh = 8 * (nrt - rs);
                  int q = rank - (F % G); if (q < 0) q += G;
                  const int on = q < nh;
                  const int uq = q >> 1, half = q & 1, rt = rs + (uq >> 2), ct = uq & 3;
                  if (on && rt >= nfull) {
                      __syncthreads();
                      if (wave == 0) { const unsigned need = (unsigned)nb; gu32* tc = (gu32*)(ws + WS_CTL) + CW_TAIL; gu32* tmo = (gu32*)(ws + WS_CTL) + CW_BAR + XB_TMO; unsigned sp = 0;
                          while ((unsigned)__builtin_amdgcn_readfirstlane(__hip_atomic_load(tc, __ATOMIC_RELAXED, __HIP_MEMORY_SCOPE_AGENT)) < need) {
                              __builtin_amdgcn_s_sleep(2);
                              if ((++sp & 255u) == 0u) { if (__builtin_amdgcn_readfirstlane(__hip_atomic_load(tmo, __ATOMIC_RELAXED, __HIP_MEMORY_SCOPE_AGENT))) break;
                                  if (sp > XB_SPIN_CAP) { if (lane == 0) __hip_atomic_fetch_add(tmo, 1u, __ATOMIC_RELAXED, __HIP_MEMORY_SCOPE_AGENT); break; } } }
                          __builtin_amdgcn_fence(__ATOMIC_ACQUIRE, "agent");
                          asm volatile("s_waitcnt vmcnt(0)" ::: "memory"); }
                      __syncthreads();
                  }
                  if (on) {
                      const int c1 = RFL(MISCI[MI_MOEC + 1]), c2 = RFL(MISCI[MI_MOEC + 2]), c3 = RFL(MISCI[MI_MOEC + 3]), c4 = RFL(MISCI[MI_MOEC + 4]), c5 = RFL(MISCI[MI_MOEC + 5]), c6 = RFL(MISCI[MI_MOEC + 6]), c7 = RFL(MISCI[MI_MOEC + 7]);
                      const int e = (rt >= c1) + (rt >= c2) + (rt >= c3) + (rt >= c4) + (rt >= c5) + (rt >= c6) + (rt >= c7);
                      const int koff = half ? 768 : 0;
                      pg8::OneUnit S{{rt, e * 4 + ct, ct}, 1};
#if I8_G2
                      pg8::Gemm g{(const bf16*)((const unsigned char*)ACTG + koff), (const bf16*)(ws + WS_WMOE_D + koff), DFFP / 2, 384, DFFP / 2};
                      pg8::EpiScaleBf16 E{half ? Y2 - (size_t)rs * 256 * DM : XG, DM, nullptr, (ACT_CLIP / 127.0f) / WQ_DM};
                      pg8::gemm_phase<pg8::EpiScaleBf16, pg8::OneUnit, true, 2>(ldsl, g, S, E);
#else
                      pg8::Gemm g{ACTG + koff, (const bf16*)(ws + WS_WMOE_D) + koff, DFFE, half ? DFFE - 768 : 768, DFFE};
                      pg8::EpiScaleBf16 E{half ? Y2 - (size_t)rs * 256 * DM : XG, DM, nullptr, 1.0f};
                      pg8::gemm_phase<pg8::EpiScaleBf16, pg8::OneUnit>(ldsl, g, S, E);
#endif
                  } }
            }
            SEAM(P + 9);
            if (PH_ON(10) && IN(P + 10)) { PHASE_WS();
                const int nrt_ = RFL(MISCI[MI_MOEC + 8]), nfull_ = nrt_ < 256 ? nrt_ : 256, ssp = (nfull_ - ((nrt_ - nfull_) * 11 + 3) / 4) * 256;
                for (int m = gw; m < M; m += NGW) {
                    const int s0 = SLOT[2 * m], s1 = SLOT[2 * m + 1]; const float g0 = TOKG[2 * m], g1 = TOKG[2 * m + 1];
#pragma unroll
                    for (int j = 0; j < 2; ++j) { const int col = lane * 8 + 512 * j;
                        float y0[8], y1[8]; unpack8(*(const GAS v4u*)(XG + (size_t)s0 * DM + col), y0); unpack8(*(const GAS v4u*)(XG + (size_t)s1 * DM + col), y1);
                        if (s0 >= ssp) { float t[8]; unpack8(*(const GAS v4u*)(Y2 + (size_t)(s0 - ssp) * DM + col), t);
#pragma unroll
                            for (int e = 0; e < 8; ++e) y0[e] += t[e]; }
                        if (s1 >= ssp) { float t[8]; unpack8(*(const GAS v4u*)(Y2 + (size_t)(s1 - ssp) * DM + col), t);
#pragma unroll
                            for (int e = 0; e < 8; ++e) y1[e] += t[e]; }
                        float xr[8]; unpack8(*(const GAS v4u*)(XB + (size_t)m * DM + col), xr);
                        GAS f32x4* op = (GAS f32x4*)(outp + (size_t)m * DM + col); f32x4 a, b2;
#pragma unroll
                        for (int e = 0; e < 4; ++e) { a[e] = xr[e] + g0 * y0[e] + g1 * y1[e]; b2[e] = xr[4 + e] + g0 * y0[4 + e] + g1 * y1[4 + e]; }
                        op[0] = a; op[1] = b2; }
                }
            }
        }
    }
#undef IN
#undef SEAM
#undef SEAM2
}

extern "C" void kernel_launch(void* const* d_in, const int* in_sizes, int n_in, void* d_out, int out_size, void* d_ws, size_t ws_size, hipStream_t stream) {
    static int grid = 0;
    if (grid == 0) {
        if (n_in != 21 || in_sizes[0] != M * DM || out_size != M * DM || ws_size < WS_END) {
            fprintf(stderr, "kernel_launch: unexpected shapes (n_in %d, in0 %d, out %d, ws %zu); nothing launched\n", n_in, n_in > 0 ? in_sizes[0] : -1, out_size, ws_size); grid = -1; return; }
        int dev = 0, cus = 0, per_cu = 0;
        if (hipGetDevice(&dev) != hipSuccess || hipDeviceGetAttribute(&cus, hipDeviceAttributeMultiprocessorCount, dev) != hipSuccess) { grid = -1; return; }
        if (hipFuncSetAttribute((const void*)fwd_kernel, hipFuncAttributeMaxDynamicSharedMemorySize, LDS_BYTES) != hipSuccess) { fprintf(stderr, "kernel_launch: hipFuncSetAttribute failed\n"); grid = -1; return; }
        if (hipOccupancyMaxActiveBlocksPerMultiprocessor(&per_cu, (const void*)fwd_kernel, NWAVES * 64, LDS_BYTES) != hipSuccess || per_cu < 1)
            fprintf(stderr, "kernel_launch: note: occupancy query reports %d workgroups per CU\n", per_cu);
        (void)hipGetLastError();
        grid = cus;
        if (grid > 256) grid = 256;
        if (grid != 256) fprintf(stderr, "kernel_launch: %d CUs; this kernel's MoE routing phases are dealt for 256 workgroups\n", grid);
    }
    if (grid < 0) return;
    (void)hipMemsetAsync((char*)d_ws + WS_CTL, 0, CTL_ZERO_BYTES, stream);
    Args a{};
    for (int i = 0; i < 21; ++i) a.in[i] = (const float*)d_in[i];
    a.out = (float*)d_out; a.ws = (unsigned char*)d_ws;
#if MK_PER_PHASE
    for (int ph = 0; ph <= 21; ++ph) { if (ph == 9 || ph == 10 || ph == 2 || ph == 12 || ph == 4 || ph == 14) continue; a.ph_lo = ph; a.ph_hi = ph + 1;
        hipLaunchKernelGGL(fwd_kernel, dim3(grid), dim3(NWAVES * 64), LDS_BYTES, stream, a); }
#else
    a.ph_lo = 0; a.ph_hi = 22;
    hipLaunchKernelGGL(fwd_kernel, dim3(grid), dim3(NWAVES * 64), LDS_BYTES, stream, a);
#endif
}
```
